# Optimizing an MI355X kernel written in HIP

```python
import math
import jax, jax.numpy as jnp
from jax import lax
import numpy as np

D_MODEL = 1024
BATCH = 4
SEQ = 4096
DEPTH = 1
DEC_BATCH = 32
DEC_SEQ = 8
PAST_LEN = 16384
PAGE_SIZE = 128

A_HEADS = 8
A_KV_GROUPS = 2
A_HPG = A_HEADS // A_KV_GROUPS
A_HEAD_DIM = 64
A_WIDTH = A_HEADS * A_HEAD_DIM
A_KV_WIDTH = A_KV_GROUPS * A_HEAD_DIM
CMP_BLOCK = 32
CMP_STRIDE = 16
SLC_BLOCK = 64
N_SELECT = 16
WINDOW = 512
Q_BLOCK = 128
ROPE_THETA = 10000.0
FORCE_SCORE = 1e4
NEG_INF = -1e30
B_HEADS = 4
B_KEY_DIM = 128
B_VAL_DIM = 128
B_KWIDTH = B_HEADS * B_KEY_DIM
B_WIDTH = B_HEADS * B_VAL_DIM
HGRN_CHUNK = 64
D_FF = 2816
FFN_CONV = 3
EPS = 1e-6
IN_WIDTHS = (A_WIDTH, 2 * A_KV_WIDTH, 2 * A_KV_WIDTH, 2 * A_KV_WIDTH, 3 * A_HEADS,
             B_KWIDTH, B_KWIDTH, B_WIDTH, B_WIDTH, 2 * D_MODEL)
D_IN = sum(IN_WIDTHS)

kernel_name = 'nsa_hgrn2_gated_merge_convffn_step'


def rms_norm(x, g):
    xf = x.astype(jnp.float32)
    y = xf * lax.rsqrt(jnp.mean(xf * xf, axis=-1, keepdims=True) + EPS)
    return (y * g.astype(jnp.float32)).astype(x.dtype)


def rope(x, pos):
    half = x.shape[-1] // 2
    inv = ROPE_THETA ** (-jnp.arange(half, dtype=jnp.float32) / half)
    ang = pos.astype(jnp.float32)[:, None] * inv[None, :]
    cos = jnp.cos(ang)[None, :, None, :]
    sin = jnp.sin(ang)[None, :, None, :]
    xf = x.astype(jnp.float32)
    x1, x2 = xf[..., :half], xf[..., half:]
    return jnp.concatenate([x1 * cos - x2 * sin, x2 * cos + x1 * sin], axis=-1).astype(x.dtype)


def masked_softmax(s, mask):
    s = jnp.where(mask, s.astype(jnp.float32), NEG_INF)
    p = jnp.exp(s - jnp.max(s, axis=-1, keepdims=True)) * mask
    return p / jnp.maximum(jnp.sum(p, axis=-1, keepdims=True), 1e-30)


def pad_time(rows):
    T = rows.shape[1]
    tp = -(-T // SLC_BLOCK) * SLC_BLOCK
    return jnp.pad(rows, ((0, 0), (0, tp - T), (0, 0), (0, 0), (0, 0)))


def mixer_features(h, pos, lb, w_in, q_norm_g, k_norm_g):
    B, T, _ = h.shape
    z = h @ w_in
    offs = np.cumsum(IN_WIDTHS)[:-1].tolist()
    q_a, kv_c, kv_s, kv_w, gate_a, q_b, f_b, i_b, g_b, mg = jnp.split(z, offs, axis=-1)
    q = rope(rms_norm(q_a.reshape(B, T, A_HEADS, A_HEAD_DIM), q_norm_g), pos)

    def kv_rows(kv, i):
        kv = kv.reshape(B, T, 2, A_KV_GROUPS, A_HEAD_DIM)
        k = rope(rms_norm(kv[:, :, 0], k_norm_g[i]), pos)
        return jnp.stack([k, kv[:, :, 1]], axis=2)

    gates = jax.nn.sigmoid(gate_a).reshape(B, T, A_HEADS, 3)
    fz = f_b.astype(jnp.float32)
    lb = lb.astype(jnp.float32)
    logf = jnp.log(lb + (1.0 - lb) * jax.nn.sigmoid(fz)).reshape(B, T, B_HEADS, B_KEY_DIM)
    kb = ((1.0 - lb) * jax.nn.sigmoid(-fz)).reshape(B, T, B_HEADS, B_KEY_DIM)
    qb = jax.nn.silu(q_b.astype(jnp.float32)).reshape(B, T, B_HEADS, B_KEY_DIM)
    vb = i_b.astype(jnp.float32).reshape(B, T, B_HEADS, B_VAL_DIM)
    gb = jax.nn.silu(g_b)
    ma, mb = jnp.split(jax.nn.sigmoid(mg), 2, axis=-1)
    return (q, kv_rows(kv_c, 0), kv_rows(kv_s, 1), kv_rows(kv_w, 2), gates, qb, kb, vb, logf, gb, ma, mb)


def compress(rows, pos_emb, w1, w2):
    B, T = rows.shape[:2]
    R = CMP_BLOCK // CMP_STRIDE
    n_chunk = T // CMP_STRIDE
    n_cmp = n_chunk - R + 1
    ch = rows.reshape(B, n_chunk, CMP_STRIDE, 2, A_KV_GROUPS, A_HEAD_DIM)
    ch = ch.transpose(0, 1, 3, 4, 2, 5).reshape(B, n_chunk, 2, A_KV_GROUPS, CMP_STRIDE * A_HEAD_DIM)
    w1r = w1.reshape(2, R, CMP_STRIDE * A_HEAD_DIM, A_HEAD_DIM)
    pre = jnp.einsum('jf,jfe->je', pos_emb.reshape(2, CMP_BLOCK * A_HEAD_DIM), w1)[None, None, :, None, :]
    for r in range(R):
        pre = pre + jnp.einsum('bcjgf,jfe->bcjge', ch, w1r[:, r])[:, r:r + n_cmp]
    out = jnp.einsum('bcjge,jed->bcjgd', jax.nn.silu(pre), w2)
    c_end = jnp.arange(n_cmp, dtype=jnp.int32) * CMP_STRIDE + (CMP_BLOCK - 1)
    return out[:, :, 0], out[:, :, 1], c_end


def select_blocks(rows):
    B, T = rows.shape[:2]
    blk = rows.reshape(B, T // SLC_BLOCK, SLC_BLOCK, 2, A_KV_GROUPS, A_HEAD_DIM)
    return blk.transpose(0, 4, 1, 2, 3, 5)


def nsa_core(q, q_pos, gates, kc, vc, c_end, kv_blk, kv_win, w_pos):
    B, Tq = q.shape[:2]
    NC = kc.shape[1]
    NS = kv_blk.shape[2]
    qg = q.reshape(B, Tq, A_KV_GROUPS, A_HPG, A_HEAD_DIM) * (A_HEAD_DIM ** -0.5)
    m_c = (c_end[None, :] <= q_pos[:, None])[None, :, None, None, :]
    p_c = masked_softmax(jnp.einsum('btghd,bcgd->btghc', qg, kc), m_c)
    o_c = jnp.einsum('btghc,bcgd->btghd', p_c.astype(vc.dtype), vc)
    c_start = jnp.arange(NC, dtype=jnp.int32) * CMP_STRIDE
    s_start = jnp.arange(NS, dtype=jnp.int32) * SLC_BLOCK
    cover = ((c_start[:, None] < s_start[None, :] + SLC_BLOCK)
             & (c_start[:, None] + CMP_BLOCK > s_start[None, :])).astype(jnp.float32)
    imp = jnp.einsum('btghc,cs->btgs', p_c, cover)
    blk = jnp.arange(NS, dtype=jnp.int32)[None, :]
    cur = (q_pos // SLC_BLOCK)[:, None]
    forced = (blk == 0) | (blk == cur) | (blk == cur - 1)
    valid = s_start[None, :] <= q_pos[:, None]
    score = jnp.where(forced[None, :, None, :], FORCE_SCORE,
                      jnp.where(valid[None, :, None, :], imp, -1.0))
    _, idx = lax.top_k(score, min(N_SELECT, NS))
    n = idx.shape[-1]
    bi = jnp.arange(B)[:, None, None, None]
    gi = jnp.arange(A_KV_GROUPS)[None, None, :, None]
    sel = kv_blk[bi, gi, idx]
    sel = sel.reshape(B, Tq, A_KV_GROUPS, n * SLC_BLOCK, 2, A_HEAD_DIM)
    sel_pos = (idx[..., None] * SLC_BLOCK + jnp.arange(SLC_BLOCK, dtype=jnp.int32)).reshape(B, Tq, A_KV_GROUPS, n * SLC_BLOCK)
    m_s = (sel_pos <= q_pos[None, :, None, None])[:, :, :, None, :]
    p_s = masked_softmax(jnp.einsum('btghd,btgkd->btghk', qg, sel[..., 0, :]), m_s)
    o_s = jnp.einsum('btghk,btgkd->btghd', p_s.astype(sel.dtype), sel[..., 1, :])
    dpos = q_pos[:, None] - w_pos[None, :]
    m_w = ((dpos >= 0) & (dpos < WINDOW) & (w_pos[None, :] >= 0))[None, :, None, None, :]
    p_w = masked_softmax(jnp.einsum('btghd,bkgd->btghk', qg, kv_win[:, :, 0]), m_w)
    o_w = jnp.einsum('btghk,bkgd->btghd', p_w.astype(kv_win.dtype), kv_win[:, :, 1])
    g = gates.reshape(B, Tq, A_KV_GROUPS, A_HPG, 3)
    o = g[..., 0:1] * o_c + g[..., 1:2] * o_s + g[..., 2:3] * o_w
    return o.reshape(B, Tq, A_WIDTH)


def hgrn2_recurrence(q, k, v, logf, s0):
    B, T, H, DK = q.shape
    C = math.gcd(T, HGRN_CHUNK)
    n = T // C

    def to_chunks(a):
        return jnp.swapaxes(a.reshape(B, n, C, *a.shape[2:]), 0, 1)

    tri = jnp.tril(jnp.ones((C, C), dtype=bool))[None, :, :, None, None]

    def step(S, inp):
        qc, kc, vc, lf = inp
        b = jnp.cumsum(lf, axis=1)
        o_inter = jnp.einsum('bthk,bhkv->bthv', qc * jnp.exp(b), S)
        d = b[:, :, None] - b[:, None, :]
        decay = jnp.where(tri, jnp.exp(jnp.where(tri, d, 0.0)), 0.0)
        A = jnp.einsum('bthk,btshk,bshk->btsh', qc, decay, kc)
        o_intra = jnp.einsum('btsh,bshv->bthv', A, vc)
        b_last = b[:, -1]
        S_new = jnp.exp(b_last)[..., None] * S + jnp.einsum('bshk,bshv->bhkv', kc * jnp.exp(b_last[:, None] - b), vc)
        return S_new, o_inter + o_intra

    S, o = lax.scan(step, s0, (to_chunks(q), to_chunks(k), to_chunks(v), to_chunks(logf)))
    return jnp.swapaxes(o, 0, 1).reshape(B, T, H, v.shape[-1]), S


def hgrn_readout(o, gb, g_norm):
    B, T = o.shape[:2]
    return rms_norm(o, g_norm).reshape(B, T, B_WIDTH).astype(gb.dtype) * gb


def merge_and_ffn(x, o_a, o_b, ma, mb, w_branch, w_out, ffn_norm_g, ffn_w_in, ffn_conv_w, ffn_conv_b, ffn_w_out, conv_buf):
    m = ma * (o_a.astype(x.dtype) @ w_branch[:A_WIDTH]) + mb * (o_b @ w_branch[A_WIDTH:])
    x = x + m @ w_out
    h = rms_norm(x, ffn_norm_g)
    a, b = jnp.split(h @ ffn_w_in, 2, axis=-1)
    T = a.shape[1]
    a_ext = jnp.concatenate([conv_buf.astype(a.dtype), a], axis=1)
    a_conv = ffn_conv_b + sum(a_ext[:, j:j + T] * ffn_conv_w[j] for j in range(FFN_CONV))
    y = x + (jax.nn.silu(a_conv) * b) @ ffn_w_out
    return y, a_ext[:, -(FFN_CONV - 1):]


def trunk_layer(xp, xs, cmp_pool, slc_pool, page_table, win_buf, hgrn_state, conv_buf, lb,
                attn_norm_g, w_in, q_norm_g, k_norm_g, cmp_pos_emb, cmp_w1, cmp_w2, hgrn_norm_g,
                w_branch, w_out, ffn_norm_g, ffn_w_in, ffn_conv_w, ffn_conv_b, ffn_w_out):
    B, T = xp.shape[:2]
    DB, TS = xs.shape[:2]
    pos_p = jnp.arange(T, dtype=jnp.int32)
    pos_s = PAST_LEN + jnp.arange(TS, dtype=jnp.int32)
    (q_p, kvc_p, kvs_p, kvw_p, gt_p, qb_p, kb_p, vb_p, lf_p, gb_p, ma_p, mb_p) = mixer_features(
        rms_norm(xp, attn_norm_g), pos_p, lb, w_in, q_norm_g, k_norm_g)
    (q_s, kvc_s, kvs_s, kvw_s, gt_s, qb_s, kb_s, vb_s, lf_s, gb_s, ma_s, mb_s) = mixer_features(
        rms_norm(xs, attn_norm_g), pos_s, lb, w_in, q_norm_g, k_norm_g)

    kc_p, vc_p, cend_p = compress(pad_time(kvc_p), cmp_pos_emb, cmp_w1, cmp_w2)
    blk_p = select_blocks(pad_time(kvs_p))
    kvw_pad = jnp.pad(kvw_p, ((0, 0), (WINDOW, 0), (0, 0), (0, 0), (0, 0)))

    def prompt_block(i):
        s0 = i * Q_BLOCK
        return nsa_core(
            lax.dynamic_slice_in_dim(q_p, s0, Q_BLOCK, axis=1),
            s0 + jnp.arange(Q_BLOCK, dtype=jnp.int32),
            lax.dynamic_slice_in_dim(gt_p, s0, Q_BLOCK, axis=1),
            kc_p, vc_p, cend_p, blk_p,
            lax.dynamic_slice_in_dim(kvw_pad, s0, WINDOW + Q_BLOCK, axis=1),
            s0 - WINDOW + jnp.arange(WINDOW + Q_BLOCK, dtype=jnp.int32))

    oa_p = lax.map(prompt_block, jnp.arange(T // Q_BLOCK, dtype=jnp.int32))
    oa_p = jnp.swapaxes(oa_p, 0, 1).reshape(B, T, A_WIDTH)

    past_c = cmp_pool[page_table].reshape(DB, -1, 2, A_KV_GROUPS, A_HEAD_DIM)
    past_s = slc_pool[page_table].reshape(DB, -1, 2, A_KV_GROUPS, A_HEAD_DIM)
    kc_s, vc_s, cend_s = compress(pad_time(jnp.concatenate([past_c, kvc_s.astype(past_c.dtype)], axis=1)),
                                  cmp_pos_emb, cmp_w1, cmp_w2)
    blk_s = select_blocks(pad_time(jnp.concatenate([past_s, kvs_s.astype(past_s.dtype)], axis=1)))
    wb = win_buf.shape[1]
    win_s = jnp.concatenate([win_buf, kvw_s.astype(win_buf.dtype)], axis=1)
    oa_s = nsa_core(q_s, pos_s, gt_s, kc_s, vc_s, cend_s, blk_s, win_s,
                    PAST_LEN - wb + jnp.arange(wb + TS, dtype=jnp.int32))

    o_p, S_p = hgrn2_recurrence(qb_p, kb_p, vb_p, lf_p, jnp.zeros((B, B_HEADS, B_KEY_DIM, B_VAL_DIM), jnp.float32))
    o_s, S_s = hgrn2_recurrence(qb_s, kb_s, vb_s, lf_s, hgrn_state.astype(jnp.float32))
    ob_p = hgrn_readout(o_p, gb_p, hgrn_norm_g)
    ob_s = hgrn_readout(o_s, gb_s, hgrn_norm_g)

    yp, conv_p = merge_and_ffn(xp, oa_p, ob_p, ma_p, mb_p, w_branch, w_out, ffn_norm_g, ffn_w_in,
                               ffn_conv_w, ffn_conv_b, ffn_w_out, jnp.zeros((B, FFN_CONV - 1, D_FF), xp.dtype))
    ys, conv_s = merge_and_ffn(xs, oa_s, ob_s, ma_s, mb_s, w_branch, w_out, ffn_norm_g, ffn_w_in,
                               ffn_conv_w, ffn_conv_b, ffn_w_out, conv_buf)
    return (yp, ys, kvc_p, kvc_s, kvs_p, kvs_s, kvw_p[:, -min(WINDOW, T):], win_s[:, -wb:],
            S_p, S_s, conv_p, conv_s)


def setup_inputs(seed: int = 0) -> dict:
    key = jax.random.key(seed)
    ks = jax.random.split(key, 24)
    f32 = jnp.float32
    n_pages = PAST_LEN // PAGE_SIZE
    n_pool = (DEC_BATCH * n_pages * 5) // 4
    win_buf = min(WINDOW, PAST_LEN)

    def nrm(k, shape, s):
        return s * jax.random.normal(k, shape, f32)

    page_table = jax.random.permutation(ks[4], n_pool)[:DEC_BATCH * n_pages].reshape(DEC_BATCH, n_pages).astype(jnp.int32)
    return {
        'x_prompt': nrm(ks[0], (BATCH, SEQ, D_MODEL), 1.0),
        'x_sample': nrm(ks[1], (DEC_BATCH, DEC_SEQ, D_MODEL), 1.0),
        'cache_cmp_kv': nrm(ks[2], (DEPTH, n_pool, PAGE_SIZE, 2, A_KV_GROUPS, A_HEAD_DIM), 1.0),
        'cache_slc_kv': nrm(ks[3], (DEPTH, n_pool, PAGE_SIZE, 2, A_KV_GROUPS, A_HEAD_DIM), 1.0),
        'page_table': page_table,
        'state_win_kv': nrm(ks[5], (DEPTH, DEC_BATCH, win_buf, 2, A_KV_GROUPS, A_HEAD_DIM), 1.0),
        'state_hgrn': nrm(ks[6], (DEPTH, DEC_BATCH, B_HEADS, B_KEY_DIM, B_VAL_DIM), 0.5),
        'state_ffn_conv': nrm(ks[7], (DEPTH, DEC_BATCH, FFN_CONV - 1, D_FF), 1.0),
        'attn_norm_g': 1.0 + nrm(ks[8], (DEPTH, D_MODEL), 0.02),
        'w_in': nrm(ks[9], (DEPTH, D_MODEL, D_IN), D_MODEL ** -0.5),
        'q_norm_g': 1.0 + nrm(ks[10], (DEPTH, A_HEAD_DIM), 0.02),
        'k_norm_g': 1.0 + nrm(ks[11], (DEPTH, 3, A_HEAD_DIM), 0.02),
        'cmp_pos_emb': nrm(ks[12], (DEPTH, 2, CMP_BLOCK, A_HEAD_DIM), 0.1),
        'cmp_w1': nrm(ks[13], (DEPTH, 2, CMP_BLOCK * A_HEAD_DIM, A_HEAD_DIM), (CMP_BLOCK * A_HEAD_DIM) ** -0.5),
        'cmp_w2': nrm(ks[14], (DEPTH, 2, A_HEAD_DIM, A_HEAD_DIM), A_HEAD_DIM ** -0.5),
        'hgrn_lb_logits': nrm(ks[15], (DEPTH + 1, B_KWIDTH), 0.5),
        'hgrn_norm_g': 1.0 + nrm(ks[16], (DEPTH, B_VAL_DIM), 0.02),
        'w_branch': nrm(ks[17], (DEPTH, A_WIDTH + B_WIDTH, D_MODEL), A_WIDTH ** -0.5),
        'w_out': nrm(ks[18], (DEPTH, D_MODEL, D_MODEL), D_MODEL ** -0.5),
        'ffn_norm_g': 1.0 + nrm(ks[19], (DEPTH, D_MODEL), 0.02),
        'ffn_w_in': nrm(ks[20], (DEPTH, D_MODEL, 2 * D_FF), D_MODEL ** -0.5),
        'ffn_conv_w': nrm(ks[21], (DEPTH, FFN_CONV, D_FF), FFN_CONV ** -0.5),
        'ffn_conv_b': nrm(ks[22], (DEPTH, D_FF), 0.01),
        'ffn_w_out': nrm(ks[23], (DEPTH, D_FF, D_MODEL), D_FF ** -0.5),
    }


def reference(x_prompt, x_sample, cache_cmp_kv, cache_slc_kv, page_table, state_win_kv, state_hgrn,
              state_ffn_conv, attn_norm_g, w_in, q_norm_g, k_norm_g, cmp_pos_emb, cmp_w1, cmp_w2,
              hgrn_lb_logits, hgrn_norm_g, w_branch, w_out, ffn_norm_g, ffn_w_in, ffn_conv_w,
              ffn_conv_b, ffn_w_out):
    lbs = jnp.cumsum(jax.nn.softmax(hgrn_lb_logits.astype(jnp.float32), axis=0), axis=0)
    yp, ys = x_prompt, x_sample
    cols = [[] for _ in range(10)]
    for l in range(DEPTH):
        yp, ys, *st = trunk_layer(
            yp, ys, cache_cmp_kv[l], cache_slc_kv[l], page_table, state_win_kv[l], state_hgrn[l],
            state_ffn_conv[l], lbs[l], attn_norm_g[l], w_in[l], q_norm_g[l], k_norm_g[l],
            cmp_pos_emb[l], cmp_w1[l], cmp_w2[l], hgrn_norm_g[l], w_branch[l], w_out[l],
            ffn_norm_g[l], ffn_w_in[l], ffn_conv_w[l], ffn_conv_b[l], ffn_w_out[l])
        for c, s in zip(cols, st):
            c.append(s)
    (cmp_kv_prompt, cmp_kv_sample, slc_kv_prompt, slc_kv_sample, win_kv_prompt, win_kv_sample,
     hgrn_prompt, hgrn_sample, ffn_conv_prompt, ffn_conv_sample) = [jnp.stack(c) for c in cols]
    return (yp, ys, cmp_kv_prompt, cmp_kv_sample, slc_kv_prompt, slc_kv_sample, win_kv_prompt,
            win_kv_sample, hgrn_prompt, hgrn_sample, ffn_conv_prompt, ffn_conv_sample)
```

```cpp
#include <hip/hip_runtime.h>
#include <cstdio>
#include <cstdint>
#define MK_ONE_LAUNCH 1
namespace pg8 {
#define PG8_LAS __attribute__((address_space(3)))
typedef unsigned short bf16_t;
typedef short bf16x8 __attribute__((ext_vector_type(8)));
typedef float f32x4 __attribute__((ext_vector_type(4)));
typedef unsigned u32x4 __attribute__((ext_vector_type(4)));
constexpr int BM = 256, BK = 64, HALF = 128, HTB = HALF * BK * 2  , STAGE_BYTES = 8 * HTB, NXCD = 8, WGM = 8;

__host__ __device__ __forceinline__ int lds_byte(int r, int c) { const int st = (r >> 4) * 2 + (c >> 5), rr = r & 15, cc = c & 31, ob = rr * 64 + cc * 2; return st * 1024 + (ob ^ (((ob >> 9) & 1) << 5)); }
__host__ __device__ __forceinline__ void stage_rc(int b, int& R, int& C) { const int st = b / 1024, sb = b % 1024, swz = sb ^ (((sb >> 9) & 1) << 5); R = (st >> 1) * 16 + swz / 64; C = (st & 1) * 32 + (swz % 64) / 2; }
__host__ __device__ __forceinline__ int perm32(int rho) { const int n = rho >> 4, i = rho & 15; return 8 * (i >> 2) + 4 * n + (i & 3); }

struct Unit { int pm, pn; };
struct Gemm { const bf16_t* A; const bf16_t* Bt; int M, N, K; };

struct StaticOrder {
    int nM, nN, nwg, G, c;
    __host__ __device__ void init(int M, int N, int G_, int c_) { nM = M / BM; nN = N / BM; nwg = nM * nN; G = G_; c = c_; }
    __host__ __device__ bool next(int i, Unit& u) const {
        const long L = (long)i * G + c; if (L >= nwg) return false;
        int wgid = (int)L; { const int q = nwg / NXCD, r = nwg % NXCD, xcd = wgid % NXCD, off = wgid / NXCD; wgid = (xcd < r ? xcd * (q + 1) : r * (q + 1) + (xcd - r) * q) + off; }
        const int nig = WGM * nN, gid = wgid / nig, fm = gid * WGM, gsz = (nM - fm) < WGM ? (nM - fm) : WGM;
        u.pm = fm + ((wgid % nig) % gsz); u.pn = (wgid % nig) / gsz; return true;
    }
    __device__ __forceinline__ void a_ready(const Unit&) const {}
    __device__ __forceinline__ void done(const Unit&) const {}
};

__device__ __forceinline__ unsigned cvt_pk_bf16(float lo, float hi) { unsigned r; asm volatile("v_cvt_pk_bf16_f32 %0, %1, %2" : "=v"(r) : "v"(lo), "v"(hi)); return r; }
typedef float f32x2 __attribute__((ext_vector_type(2)));
__device__ __forceinline__ f32x2 gelu_pk(f32x2 v) {
    const f32x2 av = __builtin_elementwise_abs(v), d = av * 0.2316418882f + 1.0f;
    f32x2 t; t.x = __builtin_amdgcn_rcpf(d.x); t.y = __builtin_amdgcn_rcpf(d.y);
    f32x2 q = t * 0.5307027145f + (-0.7265760135f); q = q * t + 0.7107068705f; q = q * t + (-0.142248368f); q = q * t + 0.127414796f; q = q * t;
    const f32x2 s = (v * v) * (-0.72134752044f);
    f32x2 e; e.x = __builtin_amdgcn_exp2f(s.x); e.y = __builtin_amdgcn_exp2f(s.y);
    const f32x2 m = v * (q * e), r = v - m;
    f32x2 o; o.x = v.x < 0.f ? m.x : r.x; o.y = v.y < 0.f ? m.y : r.y; return o;
}

template <int ACT  > struct EpiBf16 {
    static constexpr bool PERM = true, AFTER_DRAIN = false; static_assert(ACT == 0 || ACT == 1, "EpiBf16: ACT is 0 (none) or 1 (gelu_pk)");
    bf16_t* O; int ldc; const float* bias; int split_cols; size_t split_stride; float scale0;
    __device__ __forceinline__ void operator()(const f32x4 (&acc)[2][2][4][2], const Unit& u, int wr, int wc, int fr, int fq) const {
        const int row0 = u.pm * BM + wr * 64 + fr; int colt = u.pn * BM; bf16_t* base = O;
        float sc = 1.f; if (split_cols) { const int t = colt / split_cols; base += (size_t)t * split_stride; colt -= t * split_cols; if (t == 0) sc = scale0; }
        const int col0 = colt + wc * 32 + 8 * fq, bcol0 = u.pn * BM + wc * 32 + 8 * fq;
        f32x4 bv[2][2];
#pragma unroll
        for (int bj = 0; bj < 2; ++bj)
#pragma unroll
            for (int n = 0; n < 2; ++n) bv[bj][n] = bias ? *(const f32x4*)(bias + bcol0 + bj * HALF + 4 * n) : (f32x4){0.f, 0.f, 0.f, 0.f};
#pragma unroll
        for (int ai = 0; ai < 2; ++ai)
#pragma unroll
            for (int m = 0; m < 4; ++m) { bf16_t* rowp = base + (size_t)(row0 + ai * HALF + m * 16) * ldc + col0;
#pragma unroll
                for (int bj = 0; bj < 2; ++bj) { f32x4 v0 = acc[ai][bj][m][0] + bv[bj][0], v1 = acc[ai][bj][m][1] + bv[bj][1];
                    if (ACT == 1) { f32x2 a = gelu_pk((f32x2){v0[0], v0[1]}), b = gelu_pk((f32x2){v0[2], v0[3]}), c = gelu_pk((f32x2){v1[0], v1[1]}), d = gelu_pk((f32x2){v1[2], v1[3]});
                        v0 = (f32x4){a.x, a.y, b.x, b.y}; v1 = (f32x4){c.x, c.y, d.x, d.y}; }
                    v0 = v0 * sc; v1 = v1 * sc; u32x4 w; w.x = cvt_pk_bf16(v0[0], v0[1]); w.y = cvt_pk_bf16(v0[2], v0[3]); w.z = cvt_pk_bf16(v1[0], v1[1]); w.w = cvt_pk_bf16(v1[2], v1[3]);
                    *(u32x4*)(rowp + bj * HALF) = w; } }
    }
};


__device__ __forceinline__ float bf_lo(unsigned w) { return __uint_as_float(w << 16); }
__device__ __forceinline__ float bf_hi(unsigned w) { return __uint_as_float(w & 0xffff0000u); }
__device__ __forceinline__ float sigm(float x) { return __builtin_amdgcn_rcpf(1.f + __expf(-x)); }
typedef unsigned u32x2 __attribute__((ext_vector_type(2)));
template <int MODE> struct EpiBranch {
    static constexpr bool PERM = true, AFTER_DRAIN = false;
    bf16_t* T; bf16_t* Mo; const bf16_t* Z; int zld; int zoff; int ldc;
    __device__ __forceinline__ void operator()(const f32x4 (&acc)[2][2][4][2], const Unit& u, int wr, int wc, int fr, int fq) const {
        const int row0 = u.pm * BM + wr * 64 + fr, col0 = u.pn * BM + wc * 32 + 8 * fq;
#pragma unroll
        for (int am = 0; am < 4; ++am) { const int ai = am >> 1, mb = (am & 1) * 2;
            u32x2 zz[4][2][2], tw[4][2][2];
#pragma unroll
            for (int m = mb; m < mb + 2; ++m) { const size_t row = (size_t)(row0 + ai * HALF + m * 16);
#pragma unroll
                for (int bj = 0; bj < 2; ++bj)
#pragma unroll
                    for (int n = 0; n < 2; ++n) { const int col = col0 + bj * HALF + n * 4; zz[m][bj][n] = *(const u32x2*)(Z + row * zld + zoff + col); if (MODE == 1) tw[m][bj][n] = *(const u32x2*)(T + row * ldc + col); } }
#pragma unroll
            for (int m = mb; m < mb + 2; ++m) { const size_t row = (size_t)(row0 + ai * HALF + m * 16);
#pragma unroll
                for (int bj = 0; bj < 2; ++bj)
#pragma unroll
                    for (int n = 0; n < 2; ++n) { const int col = col0 + bj * HALF + n * 4; const u32x2 z2 = zz[m][bj][n];
                        f32x4 gt; gt[0] = sigm(bf_lo(z2.x)); gt[1] = sigm(bf_hi(z2.x)); gt[2] = sigm(bf_lo(z2.y)); gt[3] = sigm(bf_hi(z2.y));
                        f32x4 v = acc[ai][bj][m][n] * gt;
                        if (MODE == 1) { const u32x2 t2 = tw[m][bj][n]; f32x4 t; t[0] = bf_lo(t2.x); t[1] = bf_hi(t2.x); t[2] = bf_lo(t2.y); t[3] = bf_hi(t2.y); v = v + t; }
                        u32x2 w; w.x = cvt_pk_bf16(v[0], v[1]); w.y = cvt_pk_bf16(v[2], v[3]); *(u32x2*)((MODE == 0 ? T : Mo) + row * ldc + col) = w; } } }
    }
};
struct EpiRes {
    static constexpr bool PERM = false, AFTER_DRAIN = false;
    const float* baseP; const float* baseS; float* out; int ldc; int split;
    __device__ __forceinline__ void operator()(const f32x4 (&acc)[2][2][4][2], const Unit& u, int wr, int wc, int fr, int fq) const {
        const int row0 = u.pm * BM + wr * 64 + fr, col0 = u.pn * BM + wc * 32 + 4 * fq;
#pragma unroll
        for (int am = 0; am < 4; ++am) { const int ai = am >> 1, mb = (am & 1) * 2; f32x4 bv[4][2][2];
#pragma unroll
            for (int m = mb; m < mb + 2; ++m) { const int row = row0 + ai * HALF + m * 16;
                const float* bp = (row < split ? baseP + (size_t)row * ldc : baseS + (size_t)(row - split) * ldc) + col0;
#pragma unroll
                for (int bj = 0; bj < 2; ++bj)
#pragma unroll
                    for (int n = 0; n < 2; ++n) bv[m][bj][n] = *(const f32x4*)(bp + bj * HALF + n * 16); }
#pragma unroll
            for (int m = mb; m < mb + 2; ++m) { const int row = row0 + ai * HALF + m * 16; float* op = out + (size_t)row * ldc + col0;
#pragma unroll
                for (int bj = 0; bj < 2; ++bj)
#pragma unroll
                    for (int n = 0; n < 2; ++n) *(f32x4*)(op + bj * HALF + n * 16) = acc[ai][bj][m][n] + bv[m][bj][n]; } }
    }
};

__device__ __forceinline__ float dpp_shr1(float x) { return __int_as_float(__builtin_amdgcn_update_dpp(0, __float_as_int(x), 0x111, 0xf, 0xf, false)); }
__device__ __forceinline__ float dpp_shr2(float x) { return __int_as_float(__builtin_amdgcn_update_dpp(0, __float_as_int(x), 0x112, 0xf, 0xf, false)); }
__device__ __forceinline__ float dpp_ror1(float x) { return __int_as_float(__builtin_amdgcn_update_dpp(0, __float_as_int(x), 0x121, 0xf, 0xf, false)); }
__device__ __forceinline__ float dpp_ror2(float x) { return __int_as_float(__builtin_amdgcn_update_dpp(0, __float_as_int(x), 0x122, 0xf, 0xf, false)); }
struct EpiResNorm {
    static constexpr bool PERM = true, AFTER_DRAIN = false;
    const float* base; float* out; bf16_t* Hn; const float* gain; float* SSP; int ldc;
    __device__ __forceinline__ void operator()(const f32x4 (&acc)[2][2][4][2], const Unit& u, int wr, int wc, int fr, int fq) const {
        const int row0 = u.pm * BM + wr * 64 + fr, col0 = u.pn * BM + wc * 32 + 8 * fq;
        f32x4 gv[2][2];
#pragma unroll
        for (int bj = 0; bj < 2; ++bj)
#pragma unroll
            for (int n = 0; n < 2; ++n) gv[bj][n] = *(const f32x4*)(gain + col0 + bj * HALF + n * 4);
#pragma unroll
        for (int am = 0; am < 4; ++am) { const int ai = am >> 1, mb = (am & 1) * 2; f32x4 bv[4][2][2];
#pragma unroll
            for (int m = mb; m < mb + 2; ++m) { const size_t o = (size_t)(row0 + ai * HALF + m * 16) * ldc + col0;
#pragma unroll
                for (int bj = 0; bj < 2; ++bj)
#pragma unroll
                    for (int n = 0; n < 2; ++n) bv[m][bj][n] = *(const f32x4*)(base + o + bj * HALF + n * 4); }
#pragma unroll
            for (int m = mb; m < mb + 2; ++m) { const size_t row = (size_t)(row0 + ai * HALF + m * 16); const size_t o = row * ldc + col0; float ss = 0.f;
#pragma unroll
                for (int bj = 0; bj < 2; ++bj)
#pragma unroll
                    for (int n = 0; n < 2; ++n) { const f32x4 x = bv[m][bj][n] + acc[ai][bj][m][n]; *(f32x4*)(out + o + bj * HALF + n * 4) = x;
                        ss += (x[0] * x[0] + x[1] * x[1]) + (x[2] * x[2] + x[3] * x[3]); const f32x4 h = x * gv[bj][n];
                        u32x2 w; w.x = cvt_pk_bf16(h[0], h[1]); w.y = cvt_pk_bf16(h[2], h[3]); *(u32x2*)(Hn + o + bj * HALF + n * 4) = w; }
                ss += __shfl_xor(ss, 16); ss += __shfl_xor(ss, 32);
                if (fq == 0) SSP[row * 16 + u.pn * 4 + wc] = ss; } }
    }
};
struct EpiFfn {
    static constexpr bool PERM = true, AFTER_DRAIN = false;
    bf16_t* G; const PG8_LAS float* rsl; const PG8_LAS int* slots; const PG8_LAS float* cwl; float* RAW; float* HALO; int mp, dff;
    __device__ __forceinline__ void operator()(const f32x4 (&acc)[2][2][4][2], const Unit& u, int wr, int wc, int fr, int fq) const {
        const int ca = u.pn * 128 + wc * 32 + 8 * fq;
        f32x4 cb[2], w0[2], w1[2], w2[2];
        const bool smp = u.pm * BM >= mp;
        const int slot = slots[u.pm], ct = slots[128 + u.pn] * 512 + wc * 32 + 8 * fq;
#pragma unroll
        for (int n = 0; n < 2; ++n) { cb[n] = *(const PG8_LAS f32x4*)(cwl + ct + 4 * n); w0[n] = *(const PG8_LAS f32x4*)(cwl + ct + 128 + 4 * n); w1[n] = *(const PG8_LAS f32x4*)(cwl + ct + 256 + 4 * n); w2[n] = *(const PG8_LAS f32x4*)(cwl + ct + 384 + 4 * n); }
#pragma unroll
        for (int ai = 0; ai < 2; ++ai) { f32x4 ap[2] = {(f32x4){0.f, 0.f, 0.f, 0.f}, (f32x4){0.f, 0.f, 0.f, 0.f}};
#pragma unroll
            for (int m = 0; m < 4; ++m) { const int rl = ai * HALF + wr * 64 + m * 16 + fr, row = u.pm * BM + rl;
                const float rs = rsl[slot * 256 + rl];
                const bool rawrow = smp ? ((fr & 7) < 2) : (m == 0 && fr < 2), halorow = smp ? ((fr & 7) >= 6) : (m == 3 && fr >= 14);
                int ridx, hidx;
                if (!smp) { const int blk = row >> 6; ridx = blk * 2 + fr; hidx = blk * 2 + (fr - 14); } else { const int rr = row - mp; ridx = 512 + (rr >> 3) * 2 + (fr & 7); hidx = 512 + (rr >> 3) * 2 + (fr & 7) - 6; }
#pragma unroll
                for (int n = 0; n < 2; ++n) { const f32x4 a0 = acc[ai][0][m][n] * rs, bb = acc[ai][1][m][n] * rs; f32x4 g;
#pragma unroll
                    for (int j = 0; j < 4; ++j) { const float s1 = dpp_shr1(a0[j]), s2 = dpp_shr2(a0[j]), r1 = dpp_ror1(ap[n][j]), r2 = dpp_ror2(ap[n][j]);
                        const float a1 = fr >= 1 ? s1 : r1, a2 = fr >= 2 ? s2 : r2;
                        const float cv = cb[n][j] + w0[n][j] * a2 + w1[n][j] * a1 + w2[n][j] * a0[j]; g[j] = cv * sigm(cv) * bb[j]; }
                    if (rawrow) { *(f32x4*)(RAW + (size_t)ridx * 2 * dff + ca + 4 * n) = a0; *(f32x4*)(RAW + ((size_t)ridx * 2 + 1) * dff + ca + 4 * n) = bb; }
                    else { u32x2 w; w.x = cvt_pk_bf16(g[0], g[1]); w.y = cvt_pk_bf16(g[2], g[3]); *(u32x2*)(G + (size_t)row * dff + ca + 4 * n) = w; }
                    if (halorow) *(f32x4*)(HALO + (size_t)hidx * dff + ca + 4 * n) = a0;
                    ap[n] = a0; } } }
    }
};

__device__ __forceinline__ bool static_unit(int nM, int nN, int G, int c, int i, int& pm, int& pn) {
    const int nwg = nM * nN; const long L = (long)i * G + c; if (L >= nwg) return false;
    int wgid = (int)L; { const int q = nwg / NXCD, r = nwg % NXCD, xcd = wgid % NXCD, off = wgid / NXCD; wgid = (xcd < r ? xcd * (q + 1) : r * (q + 1) + (xcd - r) * q) + off; }
    const int nig = WGM * nN, gid = wgid / nig, fm = gid * WGM, gsz = (nM - fm) < WGM ? (nM - fm) : WGM;
    pm = fm + ((wgid % nig) % gsz); pn = (wgid % nig) / gsz; return true;
}
template <class Epi, class Sched, bool ALIGN_EPI = false, bool SP2 = false>
__device__ __forceinline__ void gemm_phase(PG8_LAS unsigned char* lds, const Gemm g, const Sched& S, const Epi& E, const int tid_in) {
    const int tid = tid_in, wid = __builtin_amdgcn_readfirstlane(tid >> 6), lane = tid & 63, wr = wid >> 2, wc = wid & 3, fr = lane & 15, fq = lane >> 4;
    const int K = g.K, nt = K / BK;
    unsigned voffA[2], voffB[2];
#pragma unroll
    for (int i = 0; i < 2; ++i) { int R, C; stage_rc(tid * 16 + i * 8192, R, C); const int Rb = Epi::PERM ? ((R & ~31) + perm32(R & 31)) : R;
        voffA[i] = (unsigned)(R * K + C) * 2u; voffB[i] = (unsigned)(Rb * K + C) * 2u; }
    const size_t kstep = (size_t)(BK * 2);
    const size_t hstep = (size_t)HALF * K * 2;
    const size_t tstep = 2 * hstep;
    const unsigned ldsw = (unsigned)wid * 1024u;
    const int aoff = lds_byte(wr * 64 + fr, fq * 8), boff = lds_byte(wc * 32 + fr, fq * 8);
#define PG8_SA(b, h) (((b) * 2 + (h)) * HTB)
#define PG8_SB(b, h) ((4 + (b) * 2 + (h)) * HTB)
#define PG8_STAGE(bufoff, gbase, voff) do { _Pragma("unroll") for (int _i = 0; _i < 2; ++_i) \
        __builtin_amdgcn_global_load_lds((const unsigned*)((const char*)(gbase) + (voff)[_i]), (PG8_LAS unsigned*)(lds + (bufoff) + ldsw + _i * 8192), 16, 0, 0); } while (0)
#define PG8_LDA(dst, b, h) do { _Pragma("unroll") for (int m = 0; m < 4; ++m) _Pragma("unroll") for (int k = 0; k < 2; ++k) dst[m][k] = *(const PG8_LAS bf16x8*)(lds + PG8_SA(b, h) + aoff + m * 2048 + k * 1024); } while (0)
#define PG8_LDB(dst, b, h) do { _Pragma("unroll") for (int n = 0; n < 2; ++n) _Pragma("unroll") for (int k = 0; k < 2; ++k) dst[n][k] = *(const PG8_LAS bf16x8*)(lds + PG8_SB(b, h) + boff + n * 2048 + k * 1024); } while (0)
#define PG8_MMA(ai, bj, At, Bt) do { __builtin_amdgcn_s_setprio(1); _Pragma("unroll") for (int m = 0; m < 4; ++m) _Pragma("unroll") for (int n = 0; n < 2; ++n) _Pragma("unroll") for (int k = 0; k < 2; ++k) \
        acc[ai][bj][m][n] = __builtin_amdgcn_mfma_f32_16x16x32_bf16(Bt[n][k], At[m][k], acc[ai][bj][m][n], 0, 0, 0); __builtin_amdgcn_s_setprio(0); } while (0)
#define PG8_WAIT_V(n) asm volatile("s_waitcnt vmcnt(" #n ")" ::: "memory")
#define PG8_WAIT_L(n) asm volatile("s_waitcnt lgkmcnt(" #n ")" ::: "memory")
#define PG8_BAR __builtin_amdgcn_s_barrier()
#define PG8_SCHED __builtin_amdgcn_sched_barrier(0)
    Unit cur, nxt; int ui = 0;
    if (!S.next(0, cur)) return;
    f32x4 acc[2][2][4][2];
#pragma unroll
    for (int a = 0; a < 2; ++a)
#pragma unroll
        for (int b = 0; b < 2; ++b)
#pragma unroll
            for (int m = 0; m < 4; ++m)
#pragma unroll
                for (int n = 0; n < 2; ++n) acc[a][b][m][n] = (f32x4){0.f, 0.f, 0.f, 0.f};
    bf16x8 At[4][2], B0[2][2], B1[2][2];
    const char* cA = (const char*)g.A + (size_t)cur.pm * tstep; const char* cB = (const char*)g.Bt + (size_t)cur.pn * tstep;
    S.a_ready(cur);
    if constexpr (SP2) {
        PG8_STAGE(PG8_SB(0, 0), cB, voffB); PG8_STAGE(PG8_SB(0, 1), cB + hstep, voffB); PG8_STAGE(PG8_SA(0, 0), cA, voffA); PG8_STAGE(PG8_SA(0, 1), cA + hstep, voffA);
        if (wr == 1) PG8_BAR;
        PG8_WAIT_V(2); PG8_BAR;
        PG8_STAGE(PG8_SB(1, 0), cB + kstep, voffB); PG8_STAGE(PG8_SA(1, 0), cA + kstep, voffA); PG8_STAGE(PG8_SB(1, 1), cB + hstep + kstep, voffB);
        PG8_WAIT_V(6); PG8_BAR;
    } else {
        PG8_STAGE(PG8_SB(0, 0), cB, voffB); PG8_STAGE(PG8_SA(0, 0), cA, voffA); PG8_STAGE(PG8_SB(0, 1), cB + hstep, voffB); PG8_STAGE(PG8_SA(0, 1), cA + hstep, voffA);
        if (wr == 1) PG8_BAR;
        PG8_WAIT_V(4); PG8_BAR;
        PG8_STAGE(PG8_SB(1, 0), cB + kstep, voffB); PG8_STAGE(PG8_SA(1, 0), cA + kstep, voffA); PG8_STAGE(PG8_SB(1, 1), cB + hstep + kstep, voffB);
        PG8_WAIT_V(6); PG8_BAR;
    }
    for (;;) {
        const bool has_next = S.next(ui + 1, nxt);
        const char* nA = has_next ? (const char*)g.A + (size_t)nxt.pm * tstep : cA; const char* nB = has_next ? (const char*)g.Bt + (size_t)nxt.pn * tstep : cB;
        for (int t = 0; t < nt; t += 2) {
            const bool last = (t == nt - 2);
            const char* a1 = cA + (size_t)(t + 1) * kstep;
            const char* a2 = last ? nA : cA + (size_t)(t + 2) * kstep; const char* b2 = last ? nB : cB + (size_t)(t + 2) * kstep;
            const char* a3 = a2 + kstep; const char* b3 = b2 + kstep;
            if (last && has_next) S.a_ready(nxt);
            if constexpr (SP2) {
            PG8_LDB(B0, 0, 0); PG8_LDB(B1, 0, 1); PG8_SCHED; PG8_LDA(At, 0, 0); PG8_STAGE(PG8_SA(1, 1), a1 + hstep, voffA);
            PG8_WAIT_V(8); PG8_WAIT_L(0); PG8_BAR; PG8_MMA(0, 0, At, B0); PG8_MMA(0, 1, At, B1); PG8_BAR; PG8_SCHED;
            PG8_LDA(At, 0, 1); PG8_STAGE(PG8_SB(0, 0), b2, voffB); PG8_STAGE(PG8_SB(0, 1), b2 + hstep, voffB); PG8_STAGE(PG8_SA(0, 0), a2, voffA);
            PG8_WAIT_V(8); PG8_WAIT_L(0); PG8_BAR; PG8_MMA(1, 0, At, B0); PG8_MMA(1, 1, At, B1); PG8_BAR; PG8_SCHED;
            PG8_LDB(B0, 1, 0); PG8_LDB(B1, 1, 1); PG8_SCHED; PG8_LDA(At, 1, 0); PG8_STAGE(PG8_SA(0, 1), a2 + hstep, voffA);
            PG8_WAIT_V(8); PG8_WAIT_L(0); PG8_BAR; PG8_MMA(0, 0, At, B0); PG8_MMA(0, 1, At, B1); PG8_BAR; PG8_SCHED;
            PG8_LDA(At, 1, 1); PG8_STAGE(PG8_SB(1, 0), b3, voffB); PG8_STAGE(PG8_SB(1, 1), b3 + hstep, voffB); PG8_STAGE(PG8_SA(1, 0), a3, voffA);
            PG8_WAIT_V(8); PG8_WAIT_L(0); PG8_BAR; PG8_MMA(1, 0, At, B0); PG8_MMA(1, 1, At, B1); PG8_BAR; PG8_SCHED;
            } else {
            PG8_LDB(B0, 0, 0); PG8_SCHED; PG8_LDA(At, 0, 0); PG8_STAGE(PG8_SA(1, 1), a1 + hstep, voffA);
            PG8_WAIT_L(8); PG8_BAR; PG8_WAIT_L(0); PG8_MMA(0, 0, At, B0); PG8_BAR; PG8_SCHED;
            PG8_LDB(B1, 0, 1); PG8_STAGE(PG8_SB(0, 0), b2, voffB);
            PG8_BAR; PG8_WAIT_L(0); PG8_MMA(0, 1, At, B1); PG8_BAR;
            PG8_LDA(At, 0, 1); PG8_STAGE(PG8_SA(0, 0), a2, voffA);
            PG8_BAR; PG8_WAIT_L(0); PG8_MMA(1, 0, At, B0); PG8_BAR; PG8_SCHED;
            PG8_STAGE(PG8_SB(0, 1), b2 + hstep, voffB);
            PG8_WAIT_V(6); PG8_BAR; PG8_MMA(1, 1, At, B1); PG8_BAR;
            PG8_LDB(B0, 1, 0); PG8_SCHED; PG8_LDA(At, 1, 0); PG8_STAGE(PG8_SA(0, 1), a2 + hstep, voffA);
            PG8_WAIT_L(8); PG8_BAR; PG8_WAIT_L(0); PG8_MMA(0, 0, At, B0); PG8_BAR; PG8_SCHED;
            PG8_LDB(B1, 1, 1); PG8_STAGE(PG8_SB(1, 0), b3, voffB);
            PG8_BAR; PG8_WAIT_L(0); PG8_MMA(0, 1, At, B1); PG8_BAR;
            PG8_LDA(At, 1, 1); PG8_STAGE(PG8_SA(1, 0), a3, voffA);
            PG8_BAR; PG8_WAIT_L(0); PG8_MMA(1, 0, At, B0); PG8_BAR; PG8_SCHED;
            PG8_STAGE(PG8_SB(1, 1), b3 + hstep, voffB);
            PG8_WAIT_V(6); PG8_BAR; PG8_MMA(1, 1, At, B1); PG8_BAR;
            }
        }
        if constexpr (ALIGN_EPI) { if (wr == 0) PG8_BAR; }
        if constexpr (!Epi::AFTER_DRAIN) { E(acc, cur, wr, wc, fr, fq); S.done(cur); }
        if (!has_next) break;
#pragma unroll
        for (int a = 0; a < 2; ++a)
#pragma unroll
            for (int b = 0; b < 2; ++b)
#pragma unroll
                for (int m = 0; m < 4; ++m)
#pragma unroll
                    for (int n = 0; n < 2; ++n) acc[a][b][m][n] = (f32x4){0.f, 0.f, 0.f, 0.f};
        cur = nxt; cA = nA; cB = nB; ++ui;
        if constexpr (ALIGN_EPI) { if (wr == 1) PG8_BAR; }
    }
    PG8_WAIT_V(0);
    if constexpr (!ALIGN_EPI) { if (wr == 0) PG8_BAR; }
    PG8_BAR;
    if constexpr (Epi::AFTER_DRAIN) { E.fused(acc, cur, wr, wc, fr, fq, lds, wid, lane); S.done(cur); }
#undef PG8_SA
#undef PG8_SB
#undef PG8_STAGE
#undef PG8_LDA
#undef PG8_LDB
#undef PG8_MMA
#undef PG8_WAIT_V
#undef PG8_WAIT_L
#undef PG8_BAR
#undef PG8_SCHED
}
}

constexpr int DM = 1024, NBAT = 4, SEQ = 4096, MP = NBAT * SEQ, DECB = 32, TS = 8, MS = DECB * TS, MT = MP + MS;
constexpr int PAST = 16384, PAGE = 128, NPG = PAST / PAGE;
constexpr int DIN = 5400, DINP = 5632, DFF = 2816, DFF2 = 5632;
constexpr int ZQ = 0, ZKC = 512, ZGA = 1280, ZQB = 1304, ZFB = 1816, ZIB = 2328, ZGB = 2840, ZMG = 3352;
constexpr int NCH_P = 256, NCH_S = 1024;
constexpr int CROWS = NBAT * NCH_P + DECB * NCH_S;
constexpr float EPS = 1e-6f;
constexpr size_t O_YP = 0, O_YS = 16777216, O_CKP = 17039360, O_CKS = 21233664, O_SKP = 21299200, O_SKS = 25493504, O_WKP = 25559040, O_WKS = 26083328,
                 O_HP = 30277632, O_HS = 30539776, O_FCP = 32636928, O_FCS = 32659456, O_END = 32839680;
constexpr size_t MiB = 1u << 20;
constexpr size_t WS_CTL = 0, CTL_ZERO_BYTES = 1 * MiB;
constexpr size_t WS_WIN = 2 * MiB, WS_WBA = 14 * MiB, WS_WBB = 15 * MiB, WS_WOUT = 16 * MiB, WS_WFIN = 18 * MiB, WS_WFOUT = 29 * MiB, WS_W1T = 35 * MiB, WS_ROPE = 36 * MiB, WS_LB = 38 * MiB, WS_CBIAS = 38 * MiB + 4096, WS_M0 = 38 * MiB + 8192;
constexpr size_t WS_H = 40 * MiB, WS_Z = 80 * MiB, WS_QR = 260 * MiB, WS_KVC = 280 * MiB, WS_KVS = 290 * MiB, WS_KVW = 300 * MiB, WS_GATES = 310 * MiB, WS_PBUF = 312 * MiB, WS_KC = 380 * MiB, WS_VC = 390 * MiB;
constexpr size_t WS_U = 400 * MiB, WS_SP = 464 * MiB, WS_OI = 496 * MiB, WS_DEC = 528 * MiB, WS_QI = 530 * MiB, WS_OCS = 546 * MiB, WS_IMPS = 547 * MiB, WS_OWS = 548 * MiB, WS_OA = 550 * MiB, WS_OB = 570 * MiB, WS_RAW = 587 * MiB, WS_VTS = 600 * MiB, WS_VTW = 606 * MiB, WS_VCT = 612 * MiB, WS_HALO = 621 * MiB, WS_T1 = 630 * MiB, WS_SSP = 696 * MiB, WS_MB = 700 * MiB, WS_X1 = 740 * MiB, WS_G = 810 * MiB, WS_END = 900 * MiB;
constexpr int CW_TMO = 0, CW_BAR = 4096, CW_XDONE = 16384;
constexpr int RING_OFF = 0, RING_BYTES = 131072;
constexpr int LDSCTL_OFF = RING_BYTES, MISC_OFF = LDSCTL_OFF + 320;
constexpr int LDS_BYTES = 163840;
constexpr int NWAVES = 8;

#define LAS __attribute__((address_space(3)))
typedef unsigned short bf16;
typedef unsigned v4u __attribute__((ext_vector_type(4)));
typedef unsigned v2u __attribute__((ext_vector_type(2)));
typedef float f32x4 __attribute__((ext_vector_type(4)));
typedef float f32x2 __attribute__((ext_vector_type(2)));
typedef short bf16x8 __attribute__((ext_vector_type(8)));
#define LDS_WAIT() asm volatile("s_waitcnt lgkmcnt(0)" ::: "memory")
typedef float f32x2_t_ __attribute__((ext_vector_type(2))); typedef __bf16 bf16x2_t_ __attribute__((ext_vector_type(2)));
__device__ __forceinline__ unsigned pkbf(float lo, float hi) { const f32x2_t_ v = {lo, hi}; const bf16x2_t_ b = __builtin_convertvector(v, bf16x2_t_); return __builtin_bit_cast(unsigned, b); }
__device__ __forceinline__ unsigned f2bf(float f) { return pkbf(f, 0.f) & 0xffffu; }
__device__ __forceinline__ unsigned pk2(float lo, float hi) { return pkbf(lo, hi); }
__device__ __forceinline__ float ex2(float x) { return __builtin_amdgcn_exp2f(x); }
constexpr float QSCALE = 0.125f * 1.4426950408889634f;
__device__ __forceinline__ float bf2f(unsigned short b) { return __uint_as_float(((unsigned)b) << 16); }
__device__ __forceinline__ float bflo(unsigned w) { return __uint_as_float(w << 16); }
__device__ __forceinline__ float bfhi(unsigned w) { return __uint_as_float(w & 0xffff0000u); }
__device__ __forceinline__ float sigm(float x) { return __builtin_amdgcn_rcpf(1.f + __expf(-x)); }
__device__ __forceinline__ float silu(float x) { return x * __builtin_amdgcn_rcpf(1.f + __expf(-x)); }
#define DPPF(old, x, ctrl, rm) __int_as_float(__builtin_amdgcn_update_dpp(__float_as_int(old), __float_as_int(x), ctrl, rm, 0xf, false))
__device__ __forceinline__ float wave_sum(float v) {
    v += DPPF(0.f, v, 0xB1, 0xf); v += DPPF(0.f, v, 0x4E, 0xf); v += DPPF(0.f, v, 0x141, 0xf); v += DPPF(0.f, v, 0x140, 0xf);
    v += DPPF(0.f, v, 0x142, 0xa); v += DPPF(0.f, v, 0x143, 0xc);
    return __int_as_float(__builtin_amdgcn_readlane(__float_as_int(v), 63));
}
__device__ __forceinline__ float wave_max(float v) {
    v = fmaxf(v, DPPF(v, v, 0xB1, 0xf)); v = fmaxf(v, DPPF(v, v, 0x4E, 0xf)); v = fmaxf(v, DPPF(v, v, 0x141, 0xf)); v = fmaxf(v, DPPF(v, v, 0x140, 0xf));
    v = fmaxf(v, DPPF(v, v, 0x142, 0xa)); v = fmaxf(v, DPPF(v, v, 0x143, 0xc));
    return __int_as_float(__builtin_amdgcn_readlane(__float_as_int(v), 63));
}
__device__ __forceinline__ int crow_base(int seq) { return seq < NBAT ? seq * NCH_P : NBAT * NCH_P + (seq - NBAT) * NCH_S; }
#define XB_TMO      128
#define XB_XCNT(j)  (256  + 64 * (j))
#define XB_XSUB(j)  (1280 + 64 * (j))
#define XB_XGEN(j)  (2304 + 64 * (j))
#define XB_TOP      3328
#define XB_TOPGEN   3392
#define XCD_BAR_WORDS 3456
#define XB_SPIN_CAP (1u << 18)

__device__ __forceinline__ unsigned xb_ld(unsigned* p)              { return __hip_atomic_load(p, __ATOMIC_RELAXED, __HIP_MEMORY_SCOPE_AGENT); }
__device__ __forceinline__ unsigned xb_add(unsigned* p, unsigned v) { return __hip_atomic_fetch_add(p, v, __ATOMIC_RELAXED, __HIP_MEMORY_SCOPE_AGENT); }
__device__ __forceinline__ unsigned xb_xcc_id() { return (unsigned)__builtin_amdgcn_s_getreg((3 << 11) | 20) & 0xFu; }
#define XB_SPIN(cond, bar) do { unsigned _sp = 0; while (cond) { __builtin_amdgcn_s_sleep(1); \
    if ((++_sp & 255u) == 0u) { if (xb_ld(&(bar)[XB_TMO])) break; if (_sp > XB_SPIN_CAP) { atomicAdd(&(bar)[XB_TMO], 1u); break; } } } } while (0)

struct XcdBarrier {
    unsigned* bar; unsigned x;
    volatile LAS unsigned* st;
};

__device__ __forceinline__ XcdBarrier xcd_barrier_post(unsigned* bar, volatile LAS unsigned* st) {
    XcdBarrier b; b.bar = bar; b.x = xb_xcc_id(); b.st = st;
    if (threadIdx.x == 0) (void)xb_add(&bar[XB_XCNT(b.x)], 1u);
    return b;
}
__device__ __forceinline__ void xcd_barrier_complete(unsigned* bar, unsigned x, unsigned& nloc, unsigned& nx) {
    const unsigned G = gridDim.x * gridDim.y * gridDim.z;
    unsigned sum, cnt, mine, sp = 0u;
    for (;;) {
        sum = 0u; cnt = 0u; mine = 0u;
#pragma unroll
        for (unsigned j = 0; j < 16; ++j) { const unsigned c = xb_ld(&bar[XB_XCNT(j)]); sum += c; cnt += (c > 0u) ? 1u : 0u; mine = (j == x) ? c : mine; }
        if (sum == G) break;
        __builtin_amdgcn_s_sleep(1);
        if ((++sp & 255u) == 0u) { if (xb_ld(&bar[XB_TMO])) break; if (sp > XB_SPIN_CAP) { atomicAdd(&bar[XB_TMO], 1u); break; } }
    }
    nloc = mine > 0u ? mine : 1u; nx = cnt > 0u ? cnt : 1u;
}

__device__ __forceinline__ void xcd_barrier(const XcdBarrier& b, const int tid_now) {
    asm volatile("s_waitcnt vmcnt(0)" ::: "memory");
    __syncthreads();
    if (tid_now == 0) {
        unsigned* bar = b.bar;
        __builtin_amdgcn_s_waitcnt(0);
        unsigned nloc = b.st[0], nx = b.st[1];
        if (nloc == 0u) { xcd_barrier_complete(bar, b.x, nloc, nx); b.st[0] = nloc; b.st[1] = nx; }
        const unsigned old = xb_add(&bar[XB_XSUB(b.x)], 1u);
        const unsigned gen = old / nloc;
        if (old + 1u == (gen + 1u) * nloc) {
            __builtin_amdgcn_fence(__ATOMIC_RELEASE, "agent");
            asm volatile("s_waitcnt vmcnt(0)" ::: "memory");
            const unsigned og = xb_add(&bar[XB_TOP], 1u);
            const unsigned tg = og / nx;
            if (og + 1u == (tg + 1u) * nx) xb_add(&bar[XB_TOPGEN], 1u);
            else XB_SPIN(xb_ld(&bar[XB_TOPGEN]) == tg, bar);
            __builtin_amdgcn_fence(__ATOMIC_ACQUIRE, "agent");
            xb_add(&bar[XB_XGEN(b.x)], 1u);
            asm volatile("s_waitcnt vmcnt(0)" ::: "memory");
        } else {
            XB_SPIN(xb_ld(&bar[XB_XGEN(b.x)]) == gen, bar);
            __builtin_amdgcn_fence(__ATOMIC_ACQUIRE, "agent");
            asm volatile("s_waitcnt vmcnt(0)" ::: "memory");
        }
    }
    __syncthreads();
}

struct Frame {
    LAS unsigned char* lds;
    int tid, lane, wave, vcu, G;
    const float *xp, *xs, *cache_cmp, *cache_slc, *st_win, *st_hgrn, *st_conv, *attn_g, *w_in, *q_g, *k_g, *pos_emb, *cmp_w1, *cmp_w2, *lb_logits, *hgrn_g, *w_branch, *w_out, *ffn_g, *ffn_w_in, *conv_w, *conv_b, *ffn_w_out;
    const int* ptab;
    float* out;
    bf16 *WIN, *WBA, *WBB, *WOUT, *WFIN, *WFOUT, *W1T, *H, *Z, *QR, *KVC, *KVS, *KVW, *KC, *VC, *VCT, *VTS, *VTW, *SP, *QI, *OA, *OB, *MB, *GB;
    float *ROPE, *LB, *CBIAS, *M0, *RAW, *HALO, *SSP, *OCS, *IMPS, *OWS, *GATES, *PBUF, *U, *OI, *DEC, *T1, *X1;
};

__device__ __forceinline__ int ffn_perm(int n) { return n < DFF ? (n >> 7) * 256 + (n & 127) : ((n - DFF) >> 7) * 256 + 128 + ((n - DFF) & 127); }
__device__ __forceinline__ void transpose_load(float (&tv)[32], const float* W, int ld, int N, int Nvalid, int item, int lane) {
    const int nblk = N / 32, kb = item / nblk, nb = item % nblk, k0 = 64 * kb, nn = 32 * nb + (lane & 31);
#pragma unroll
    for (int i = 0; i < 32; ++i) { const int kk = 2 * i + (lane >> 5); tv[i] = nn < Nvalid ? W[(size_t)(k0 + kk) * ld + nn] : 0.f; }
}
__device__ __forceinline__ void transpose_item(const float* W, int ld, int K, int N, int Nvalid, bf16* WT, int row_off, LAS float* scr, int item, int lane, bool perm = false) {
    const int nblk = N / 32, kb = item / nblk, nb = item % nblk, k0 = 64 * kb, n0 = 32 * nb;
    const int nn = n0 + (lane & 31);
    float tv[32];
#pragma unroll
    for (int i = 0; i < 32; ++i) { const int kk = 2 * i + (lane >> 5); tv[i] = nn < Nvalid ? W[(size_t)(k0 + kk) * ld + nn] : 0.f; }
#pragma unroll
    for (int i = 0; i < 32; ++i) { const int kk = 2 * i + (lane >> 5); scr[kk * 33 + (lane & 31)] = tv[i]; }
    LDS_WAIT();
    const int c = lane & 7;
#pragma unroll
    for (int j = 0; j < 4; ++j) { const int n = (lane >> 3) + 8 * j; const LAS float* s = scr + (8 * c) * 33 + n;
        v4u o; o.x = pk2(s[0 * 33], s[1 * 33]); o.y = pk2(s[2 * 33], s[3 * 33]); o.z = pk2(s[4 * 33], s[5 * 33]); o.w = pk2(s[6 * 33], s[7 * 33]);
        *(v4u*)(WT + (size_t)(row_off + (perm ? ffn_perm(n0 + n) : n0 + n)) * K + k0 + 8 * c) = o; }
    LDS_WAIT();
}
__device__ __forceinline__ void rms_row_bf16(const float* xrow, const float* g, bf16* orow, int lane) {
    const f32x4* xr = (const f32x4*)xrow + lane; const f32x4* gr = (const f32x4*)g + lane;
    f32x4 v[4]; float s = 0.f;
#pragma unroll
    for (int j = 0; j < 4; ++j) { v[j] = xr[64 * j]; s += (v[j].x * v[j].x + v[j].y * v[j].y) + (v[j].z * v[j].z + v[j].w * v[j].w); }
    const float rs = rsqrtf(wave_sum(s) * (1.f / DM) + EPS);
    unsigned long long* o8 = (unsigned long long*)orow + lane;
#pragma unroll
    for (int j = 0; j < 4; ++j) { const f32x4 gg = gr[64 * j]; o8[64 * j] = (unsigned long long)pk2(v[j].x * rs * gg.x, v[j].y * rs * gg.y) | ((unsigned long long)pk2(v[j].z * rs * gg.z, v[j].w * rs * gg.w) << 32); }
}
__device__ __forceinline__ void p0_prologue(const Frame& F) {
    LAS float* scr = (LAS float*)(F.lds + RING_OFF + F.wave * 16384);
    const int gw = F.vcu * NWAVES + F.wave, NGW = F.G * NWAVES, lane = F.lane;
    constexpr int I_IN = 16 * (DINP / 32), I_BR = 8 * 32, I_OUT = 16 * 32, I_FIN = 16 * (DFF2 / 32), I_FOUT = (DFF / 64) * 32, I_W1 = 16 * 2;
    constexpr int NITEMS = I_IN + 2 * I_BR + I_OUT + I_FIN + I_FOUT + 4 * I_W1;
    for (int it = gw; it < NITEMS; it += NGW) {
        int r = it;
        if (r < I_IN) { transpose_item(F.w_in, DIN, DM, DINP, DIN, F.WIN, 0, scr, r, lane); continue; } r -= I_IN;
        if (r < I_BR) { transpose_item(F.w_branch, DM, 512, DM, DM, F.WBA, 0, scr, r, lane); continue; } r -= I_BR;
        if (r < I_BR) { transpose_item(F.w_branch + (size_t)512 * DM, DM, 512, DM, DM, F.WBB, 0, scr, r, lane); continue; } r -= I_BR;
        if (r < I_OUT) { transpose_item(F.w_out, DM, DM, DM, DM, F.WOUT, 0, scr, r, lane); continue; } r -= I_OUT;
        if (r < I_FIN) { transpose_item(F.ffn_w_in, DFF2, DM, DFF2, DFF2, F.WFIN, 0, scr, r, lane, true); continue; } r -= I_FIN;
        if (r < I_FOUT) { transpose_item(F.ffn_w_out, DM, DFF, DM, DM, F.WFOUT, 0, scr, r, lane); continue; } r -= I_FOUT;
        { const int jr = r / I_W1, rr = r % I_W1;
          transpose_item(F.cmp_w1 + (size_t)jr * 1024 * 64, 64, 1024, 64, 64, F.W1T, jr * 64, scr, rr, lane); }
    }
    for (int m = gw; m < MT; m += 2 * NGW) {
        const int m2 = m + NGW; const bool has2 = m2 < MT;
        const f32x4* x0 = (const f32x4*)(m < MP ? F.xp + (size_t)m * DM : F.xs + (size_t)(m - MP) * DM) + lane;
        const f32x4* x1 = (const f32x4*)(!has2 ? (const float*)x0 - lane * 4 : (m2 < MP ? F.xp + (size_t)m2 * DM : F.xs + (size_t)(m2 - MP) * DM)) + lane;
        const f32x4* gr = (const f32x4*)F.attn_g + lane;
        f32x4 v0[4], v1[4]; float s0 = 0.f, s1 = 0.f;
#pragma unroll
        for (int j = 0; j < 4; ++j) { v0[j] = x0[64 * j]; v1[j] = x1[64 * j]; }
#pragma unroll
        for (int j = 0; j < 4; ++j) { s0 += (v0[j].x * v0[j].x + v0[j].y * v0[j].y) + (v0[j].z * v0[j].z + v0[j].w * v0[j].w); s1 += (v1[j].x * v1[j].x + v1[j].y * v1[j].y) + (v1[j].z * v1[j].z + v1[j].w * v1[j].w); }
        const float r0 = rsqrtf(wave_sum(s0) * (1.f / DM) + EPS), r1 = rsqrtf(wave_sum(s1) * (1.f / DM) + EPS);
        unsigned long long* o0 = (unsigned long long*)(F.H + (size_t)m * DM) + lane; unsigned long long* o1 = (unsigned long long*)(F.H + (size_t)(has2 ? m2 : m) * DM) + lane;
#pragma unroll
        for (int j = 0; j < 4; ++j) { const f32x4 gg = gr[64 * j];
            o0[64 * j] = (unsigned long long)pk2(v0[j].x * r0 * gg.x, v0[j].y * r0 * gg.y) | ((unsigned long long)pk2(v0[j].z * r0 * gg.z, v0[j].w * r0 * gg.w) << 32);
            if (has2) o1[64 * j] = (unsigned long long)pk2(v1[j].x * r1 * gg.x, v1[j].y * r1 * gg.y) | ((unsigned long long)pk2(v1[j].z * r1 * gg.z, v1[j].w * r1 * gg.w) << 32); }
    }
    const int gt = (F.vcu * NWAVES * 64) + F.tid, NGT = F.G * NWAVES * 64;
    for (int e = gt; e < (SEQ + TS) * 32; e += NGT) {
        const int p = e >> 5, i = e & 31; const double pos = (double)(p < SEQ ? p : PAST + (p - SEQ));
        const double inv = exp(-(double)i * (9.210340371976184 / 32.0));
        double a = pos * inv; const double k = rint(a * 0.15915494309189535); a = fma(-k, 6.283185307179586, a); a = fma(-k, 2.4492935982947064e-16, a);
        const float af = (float)a; F.ROPE[2 * e] = cosf(af); F.ROPE[2 * e + 1] = sinf(af);
    }
    for (int e = gt; e < 512; e += NGT) { const float l0 = F.lb_logits[e], l1 = F.lb_logits[512 + e]; F.LB[e] = 1.f / (1.f + expf(l1 - l0)); }
    for (int o = gw; o < 128; o += NGW) { const int j = o >> 6, e = o & 63; float s = 0.f;
        float pe[32], ww[32];
#pragma unroll
        for (int i = 0; i < 32; ++i) { const int f = lane + 64 * i; pe[i] = F.pos_emb[j * 2048 + f]; ww[i] = F.cmp_w1[((size_t)j * 2048 + f) * 64 + e]; }
#pragma unroll
        for (int i = 0; i < 32; ++i) s += pe[i] * ww[i];
        s = wave_sum(s); if (lane == 0) F.CBIAS[o] = s; }
    if (gw == 0) { float mq = fabsf(F.q_g[lane]), mk = fmaxf(fmaxf(fabsf(F.k_g[lane]), fabsf(F.k_g[64 + lane])), fabsf(F.k_g[128 + lane])); mq = wave_max(mq); mk = wave_max(mk);
        if (lane == 0) F.M0[0] = fminf(QSCALE * 64.f * mq * mk, 60.f); }
    for (int e0 = gt; e0 < DECB * 504 * 64; e0 += 8 * NGT) {
        f32x4 cv[8];
#pragma unroll
        for (int i = 0; i < 8; ++i) { const int e = e0 + i * NGT; if (e < DECB * 504 * 64) { const int b = e / (504 * 64), w = e % (504 * 64); cv[i] = ((const f32x4*)F.st_win)[(size_t)b * 512 * 64 + 8 * 64 + w]; } }
#pragma unroll
        for (int i = 0; i < 8; ++i) { const int e = e0 + i * NGT; if (e < DECB * 504 * 64) { const int b = e / (504 * 64), w = e % (504 * 64); ((f32x4*)(F.out + O_WKS))[(size_t)b * 512 * 64 + w] = cv[i]; } }
    }
}

template <int NR> __device__ __forceinline__ void p2_block(const Frame& F, const int rfirst, const int lane, const float qg, const float kg0, const float kg1, const float kg2) {
    {
        const bool smp = rfirst >= MP;
        float vt[4][NR];
        bf16 zv[2][21];
#define P2_LOAD(i_) do { const bf16* z__ = F.Z + (size_t)(rfirst + (i_)) * DINP; _Pragma("unroll") for (int q__ = 0; q__ < 20; ++q__) zv[(i_) & 1][q__] = z__[q__ * 64 + lane]; zv[(i_) & 1][20] = z__[ZGA + (lane < 24 ? lane : 0)]; } while (0)
        P2_LOAD(0);
#pragma unroll
        for (int i = 0; i < NR; ++i) {
            if (i + 1 < NR) P2_LOAD(i + 1);
            const int r = rfirst + i, rr = r - MP;
            const bf16* zrow = zv[i & 1];
            const int p = smp ? SEQ + (rr % TS) : (r % SEQ);
            const f32x2 cs = ((const f32x2*)F.ROPE)[p * 32 + (lane & 31)];
            const float c = cs.x, s = cs.y;
#pragma unroll
            for (int hd = 0; hd < 8; ++hd) {
                const float x = bf2f(zrow[hd]); const float ss = wave_sum(x * x);
                const float y = x * rsqrtf(ss * (1.f / 64.f) + EPS) * qg; const float pr = __shfl_xor(y, 32);
                const float o = lane < 32 ? y * c - pr * s : y * c + pr * s;
                F.QR[(size_t)r * 512 + hd * 64 + lane] = (bf16)f2bf(o * QSCALE);
            }
#pragma unroll
            for (int br = 0; br < 3; ++br) {
                const float kg = br == 0 ? kg0 : (br == 1 ? kg1 : kg2);
                bf16* kvb = (br == 0 ? F.KVC : (br == 1 ? F.KVS : F.KVW)) + (size_t)r * 256;
                float* od;
                if (!smp) { const int b = r / SEQ, t = r % SEQ;
                    if (br == 0) od = F.out + O_CKP + (size_t)r * 256; else if (br == 1) od = F.out + O_SKP + (size_t)r * 256;
                    else od = t >= SEQ - 512 ? F.out + O_WKP + ((size_t)b * 512 + (t - (SEQ - 512))) * 256 : nullptr;
                } else { const int b = rr / TS, t = rr % TS;
                    if (br == 0) od = F.out + O_CKS + (size_t)rr * 256; else if (br == 1) od = F.out + O_SKS + (size_t)rr * 256;
                    else od = F.out + O_WKS + ((size_t)b * 512 + 504 + t) * 256;
                }
#pragma unroll
                for (int part = 0; part < 4; ++part) {
                    const float x = bf2f(zrow[8 + br * 4 + part]); float o = x;
                    if (part < 2) { const float ss = wave_sum(x * x); const float y = x * rsqrtf(ss * (1.f / 64.f) + EPS) * kg; const float pr = __shfl_xor(y, 32);
                        o = lane < 32 ? y * c - pr * s : y * c + pr * s; }
                    kvb[part * 64 + lane] = (bf16)f2bf(o);
                    if (od) od[part * 64 + lane] = o;
                    if (part >= 2 && br >= 1) vt[(br - 1) * 2 + (part - 2)][i % NR] = o;
                }
            }
            if (lane < 24) F.GATES[(size_t)r * 24 + lane] = sigm(bf2f(zrow[20]));
        }
#undef P2_LOAD
        if (NR == 8) { const int r0 = rfirst, b = r0 / SEQ, t0 = r0 % SEQ;
#pragma unroll
            for (int q = 0; q < 4; ++q) { v4u w; w.x = pkbf(vt[q][0], vt[q][1]); w.y = pkbf(vt[q][2 % NR], vt[q][3 % NR]); w.z = pkbf(vt[q][4 % NR], vt[q][5 % NR]); w.w = pkbf(vt[q][6 % NR], vt[q][7 % NR]);
                *(v4u*)((q < 2 ? F.VTS : F.VTW) + ((size_t)(b * 2 + (q & 1)) * 64 + lane) * SEQ + t0) = w; } }
    }
}
__device__ __forceinline__ void p2_features(const Frame& F) {
    const int gw = F.vcu * NWAVES + F.wave, NGW = F.G * NWAVES, lane = F.lane;
    const float qg = F.q_g[lane]; const float kg0 = F.k_g[lane], kg1 = F.k_g[64 + lane], kg2 = F.k_g[128 + lane];
    for (int rb = gw; rb < MP / 8; rb += NGW) p2_block<8>(F, rb * 8, lane, qg, kg0, kg1, kg2);
    for (int r = MP + gw; r < MT; r += NGW) p2_block<1>(F, r, lane, qg, kg0, kg1, kg2);
}

__device__ __forceinline__ void cmp_gemm_task(const Frame& F, int task, int lane) {
    const int nt = task & 7, t8 = task >> 3, seq = t8 >> 6, jg = (t8 >> 4) & 3, tile = t8 & 15;
    const int j = jg >> 1, c0 = tile * 16, Q = lane >> 4, fr = lane & 15;
    f32x4 acc[2] = {(f32x4){0.f, 0.f, 0.f, 0.f}, (f32x4){0.f, 0.f, 0.f, 0.f}};
    const bf16* ab = F.KVC + ((size_t)seq * SEQ + 16 * (c0 + fr)) * 256 + jg * 64 + 8 * Q;
    const bf16* wb = F.W1T + (size_t)(j * 128 + nt * 16 + fr) * 1024 + 8 * Q;
#pragma unroll 16
    for (int ks = 0; ks < 32; ++ks) {
        const bf16x8 B = *(const bf16x8*)(wb + ks * 32), A = *(const bf16x8*)(ab + (ks >> 1) * 256 + (ks & 1) * 32);
        acc[ks & 1] = __builtin_amdgcn_mfma_f32_16x16x32_bf16(A, B, acc[ks & 1], 0, 0, 0);
    }
    const f32x4 r = acc[0] + acc[1];
    float* pb = F.PBUF + ((size_t)jg * CROWS + crow_base(seq) + c0) * 128;
#pragma unroll
    for (int rg = 0; rg < 4; ++rg) pb[(size_t)(4 * Q + rg) * 128 + nt * 16 + fr] = r[rg];
}
__device__ __forceinline__ void cmp_tail_run(const Frame& F, int run, int lane) {
    int seq, jg, c0, nblk;
    if (run < 128) { seq = run >> 5; jg = (run >> 3) & 3; c0 = (run & 7) * 32; nblk = 255; } else { const int u = run - 128; seq = NBAT + (u >> 7); jg = (u >> 5) & 3; c0 = (u & 31) * 32; nblk = 1023; }
    const int j = jg >> 1, g = jg & 1;
    float w2r[64];
#pragma unroll
    for (int e = 0; e < 64; ++e) w2r[e] = F.cmp_w2[(size_t)j * 4096 + e * 64 + lane];
    const float cb = F.CBIAS[j * 64 + lane];
    const float* pb = F.PBUF + ((size_t)jg * CROWS + crow_base(seq)) * 128;
    bf16* dst = (j == 0 ? F.KC : F.VC) + ((size_t)g * CROWS + crow_base(seq)) * 64;
    bf16* dstT = F.VCT + ((size_t)g * 64 + lane) * CROWS + crow_base(seq);
    float pa[2][4], pc[2][4];
#define CT_LOAD(s_, cc_) do { _Pragma("unroll") for (int u = 0; u < 4; ++u) { const int c__ = (cc_) + u; pa[s_][u] = pb[(size_t)c__ * 128 + lane]; pc[s_][u] = pb[(size_t)(c__ + 1 < NCH_S ? c__ + 1 : c__) * 128 + 64 + lane]; } } while (0)
#define CT_STEP(s_, cc_) do { float o4[4]; _Pragma("unroll") for (int u = 0; u < 4; ++u) { const int c = (cc_) + u; const float sv = silu(cb + pa[s_][u] + pc[s_][u]); float o = 0.f; \
        _Pragma("unroll") for (int e = 0; e < 64; ++e) o += __int_as_float(__builtin_amdgcn_readlane(__float_as_int(sv), e)) * w2r[e]; \
        o = c < nblk ? o : 0.f; o4[u] = o; dst[(size_t)c * 64 + lane] = (bf16)f2bf(o); } \
        if (j == 1) { v2u w__; w__.x = pkbf(o4[0], o4[1]); w__.y = pkbf(o4[2], o4[3]); *(v2u*)(dstT + (cc_)) = w__; } } while (0)
    CT_LOAD(0, c0);
#pragma unroll 1
    for (int cc = c0; cc < c0 + 32; cc += 8) {
        CT_LOAD(1, cc + 4);
        CT_STEP(0, cc);
        if (cc + 8 < c0 + 32) CT_LOAD(0, cc + 8);
        CT_STEP(1, cc + 4);
    }
#undef CT_LOAD
#undef CT_STEP
}

__device__ __forceinline__ void cmp_tail_flat(const Frame& F, int w, int lane) {
    const int jg = w >> 9, wl = w & 511, j = jg >> 1, g = jg & 1;
    const int start = wl < 256 ? 68 * wl : 17408 + 64 * (wl - 256), nrows = wl < 256 ? 68 : 64;
    float w2r[64];
#pragma unroll
    for (int e = 0; e < 64; ++e) w2r[e] = F.cmp_w2[(size_t)j * 4096 + e * 64 + lane];
    const float cb = F.CBIAS[j * 64 + lane];
    const float* pb = F.PBUF + (size_t)jg * CROWS * 128;
    bf16* dst = (j == 0 ? F.KC : F.VC) + (size_t)g * CROWS * 64;
    bf16* dstT = F.VCT + ((size_t)g * 64 + lane) * CROWS;
    float pa[2][4], pc[2][4];
#define CT_LOAD(s_, cc_) do { _Pragma("unroll") for (int u = 0; u < 4; ++u) { const int c__ = (cc_) + u; pa[s_][u] = pb[(size_t)c__ * 128 + lane]; pc[s_][u] = pb[(size_t)(c__ + 1 < CROWS ? c__ + 1 : c__) * 128 + 64 + lane]; } } while (0)
#define CT_STEP(s_, cc_) do { float o4[4]; _Pragma("unroll") for (int u = 0; u < 4; ++u) { const int cr = (cc_) + u; const float sv = silu(cb + pa[s_][u] + pc[s_][u]); float o = 0.f; \
        _Pragma("unroll") for (int e = 0; e < 64; ++e) o += __int_as_float(__builtin_amdgcn_readlane(__float_as_int(sv), e)) * w2r[e]; \
        const bool keep = cr < NBAT * NCH_P ? ((cr & (NCH_P - 1)) < NCH_P - 1) : (((cr - NBAT * NCH_P) & (NCH_S - 1)) < NCH_S - 1);     \
        o = keep ? o : 0.f; o4[u] = o; dst[(size_t)cr * 64 + lane] = (bf16)f2bf(o); } \
        if (j == 1) { v2u w__; w__.x = pkbf(o4[0], o4[1]); w__.y = pkbf(o4[2], o4[3]); *(v2u*)(dstT + (cc_)) = w__; } } while (0)
    CT_LOAD(0, start);
#pragma unroll 1
    for (int cc = start; cc < start + nrows; cc += 8) {
        const bool two = cc + 4 < start + nrows;
        if (two) CT_LOAD(1, cc + 4);
        CT_STEP(0, cc);
        if (cc + 8 < start + nrows) CT_LOAD(0, cc + 8);
        if (two) CT_STEP(1, cc + 4);
    }
#undef CT_LOAD
#undef CT_STEP
}

__device__ __forceinline__ void cmp_tail_mfma(const Frame& F, int w, int lane) {
    const int jg = w >> 9, wl = w & 511, j = jg >> 1, g = jg & 1, fr = lane & 15, Q = lane >> 4;
    bf16x8 Bw[4][2];
#pragma unroll
    for (int nt = 0; nt < 4; ++nt)
#pragma unroll
        for (int ks = 0; ks < 2; ++ks) { float t[8];
#pragma unroll
            for (int i = 0; i < 8; ++i) t[i] = F.cmp_w2[(size_t)j * 4096 + (32 * ks + 8 * Q + i) * 64 + 16 * nt + fr];
            v4u u; u.x = pkbf(t[0], t[1]); u.y = pkbf(t[2], t[3]); u.z = pkbf(t[4], t[5]); u.w = pkbf(t[6], t[7]); Bw[nt][ks] = __builtin_bit_cast(bf16x8, u); }
    f32x4 cbv[4];
#pragma unroll
    for (int q = 0; q < 4; ++q) cbv[q] = *(const f32x4*)(F.CBIAS + j * 64 + 32 * (q >> 1) + 8 * Q + 4 * (q & 1));
    const float* pb = F.PBUF + (size_t)jg * CROWS * 128;
    bf16* dst = (j == 0 ? F.KC : F.VC) + (size_t)g * CROWS * 64;
    bf16* dstT = F.VCT + (size_t)g * 64 * CROWS;
    const bool five = wl < 64;
    f32x4 la[2][4], lc[2][4];
#define CM_TILE(i_) ((i_) < 4 ? 4 * wl + (i_) : 2048 + wl)
#define CM_LOAD(s_, tile_) do { const int r__ = (tile_) * 16 + fr, r1__ = r__ + 1 < CROWS ? r__ + 1 : r__; const float* pa__ = pb + (size_t)r__ * 128 + 8 * Q; const float* pc__ = pb + (size_t)r1__ * 128 + 64 + 8 * Q; \
        _Pragma("unroll") for (int q = 0; q < 4; ++q) { la[s_][q] = *(const f32x4*)(pa__ + 32 * (q >> 1) + 4 * (q & 1)); lc[s_][q] = *(const f32x4*)(pc__ + 32 * (q >> 1) + 4 * (q & 1)); } } while (0)
#define CM_STEP(s_, tile_) do { bf16x8 Af[2]; \
        _Pragma("unroll") for (int ks = 0; ks < 2; ++ks) { float sv[8]; \
            _Pragma("unroll") for (int i = 0; i < 8; ++i) { const int q = 2 * ks + (i >> 2); sv[i] = silu(cbv[q][i & 3] + la[s_][q][i & 3] + lc[s_][q][i & 3]); } \
            v4u u; u.x = pkbf(sv[0], sv[1]); u.y = pkbf(sv[2], sv[3]); u.z = pkbf(sv[4], sv[5]); u.w = pkbf(sv[6], sv[7]); Af[ks] = __builtin_bit_cast(bf16x8, u); } \
        const int cr0 = (tile_) * 16 + 4 * Q; bool keep[4]; \
        _Pragma("unroll") for (int rg = 0; rg < 4; ++rg) { const int cr = cr0 + rg; keep[rg] = cr < NBAT * NCH_P ? ((cr & (NCH_P - 1)) < NCH_P - 1) : (((cr - NBAT * NCH_P) & (NCH_S - 1)) < NCH_S - 1); }     \
        _Pragma("unroll") for (int nt = 0; nt < 4; ++nt) { f32x4 acc = (f32x4){0.f, 0.f, 0.f, 0.f}; \
            acc = __builtin_amdgcn_mfma_f32_16x16x32_bf16(Af[0], Bw[nt][0], acc, 0, 0, 0); acc = __builtin_amdgcn_mfma_f32_16x16x32_bf16(Af[1], Bw[nt][1], acc, 0, 0, 0); \
            _Pragma("unroll") for (int rg = 0; rg < 4; ++rg) { acc[rg] = keep[rg] ? acc[rg] : 0.f; dst[(size_t)(cr0 + rg) * 64 + 16 * nt + fr] = (bf16)f2bf(acc[rg]); } \
            if (j == 1) { v2u w__; w__.x = pkbf(acc[0], acc[1]); w__.y = pkbf(acc[2], acc[3]); *(v2u*)(dstT + (size_t)(16 * nt + fr) * CROWS + cr0) = w__; } } } while (0)
    CM_LOAD(0, CM_TILE(0));
    CM_LOAD(1, CM_TILE(1)); CM_STEP(0, CM_TILE(0));
    CM_LOAD(0, CM_TILE(2)); CM_STEP(1, CM_TILE(1));
    CM_LOAD(1, CM_TILE(3)); CM_STEP(0, CM_TILE(2));
    if (five) CM_LOAD(0, CM_TILE(4));
    CM_STEP(1, CM_TILE(3));
    if (five) CM_STEP(0, CM_TILE(4));
#undef CM_TILE
#undef CM_LOAD
#undef CM_STEP
}

constexpr int HG_QT = 0, HG_KT = 17408, HG_KHT = 34816, HG_VT = 53248, HG_AB = 71680, HG_TOT = 80896;
constexpr int HP = 136, HPT = 72;
__device__ __forceinline__ void hgrn_a_task(const Frame& F, int task) {
    const int tid = F.tid, lane = F.lane, wave = F.wave;
    const int h = task & 3, bn = task >> 2, r0 = bn * 64;
    LAS bf16* QT = (LAS bf16*)(F.lds + HG_QT); LAS bf16* KT = (LAS bf16*)(F.lds + HG_KT); LAS bf16* KHT = (LAS bf16*)(F.lds + HG_KHT);
    LAS bf16* VT = (LAS bf16*)(F.lds + HG_VT); LAS bf16* AB = (LAS bf16*)(F.lds + HG_AB); LAS float* TOT = (LAS float*)(F.lds + HG_TOT);
    const int k = tid & 127, tq = tid >> 7;
    const float lbk = F.LB[h * 128 + k];
    float lf[16], kb[16], qs[16];
    float run = 0.f;
#pragma unroll
    for (int i = 0; i < 16; ++i) { const int t = tq * 16 + i; const bf16* z = F.Z + (size_t)(r0 + t) * DINP + h * 128 + k;
        const float fz = bf2f(z[ZFB]); const float sg = sigm(fz); const float f = lbk + (1.f - lbk) * sg;
        run += __logf(f); lf[i] = run; kb[i] = (1.f - lbk) * (1.f - sg); qs[i] = silu(bf2f(z[ZQB]));
        VT[k * HPT + t] = z[ZIB]; }
    TOT[tq * 128 + k] = run;
    __syncthreads();
    const float t0 = TOT[k], t1 = TOT[128 + k], t2 = TOT[256 + k], t3 = TOT[384 + k];
    const float off = tq == 0 ? 0.f : (tq == 1 ? t0 : (tq == 2 ? t0 + t1 : t0 + t1 + t2));
    const float bref = t0 + t1, blast = (t0 + t1) + (t2 + t3);
#pragma unroll
    for (int i = 0; i < 16; ++i) { const int t = tq * 16 + i; const float b = off + lf[i];
        QT[t * HP + k] = (bf16)f2bf(qs[i] * __expf(b - bref));
        KT[t * HP + k] = (bf16)f2bf(kb[i] * __expf(bref - b));
        KHT[k * HPT + t] = (bf16)f2bf(kb[i] * __expf(blast - b));
        F.QI[(size_t)(r0 + t) * 512 + h * 128 + k] = (bf16)f2bf(qs[i] * __expf(b)); }
    if (tq == 0) F.DEC[(size_t)task * 128 + k] = __expf(blast);
    __syncthreads();
    const int fr = lane & 15, Q = lane >> 4;
    { const int mt = wave >> 1;
#pragma unroll
      for (int q = 0; q < 2; ++q) { const int nt = 2 * (wave & 1) + q; f32x4 acc = (f32x4){0.f, 0.f, 0.f, 0.f};
        if (nt <= mt) {
#pragma unroll
            for (int ks = 0; ks < 4; ++ks) { const bf16x8 a = *(const LAS bf16x8*)(QT + (16 * mt + fr) * HP + 32 * ks + 8 * Q); const bf16x8 b = *(const LAS bf16x8*)(KT + (16 * nt + fr) * HP + 32 * ks + 8 * Q);
                acc = __builtin_amdgcn_mfma_f32_16x16x32_bf16(a, b, acc, 0, 0, 0); } }
#pragma unroll
        for (int rg = 0; rg < 4; ++rg) { const int t = 16 * mt + 4 * Q + rg, s = 16 * nt + fr; AB[t * HPT + s] = (bf16)f2bf(s <= t ? acc[rg] : 0.f); } } }
    __syncthreads();
    { const int mt = wave >> 1;
#pragma unroll
      for (int q = 0; q < 4; ++q) { const int nt = 4 * (wave & 1) + q; f32x4 acc = (f32x4){0.f, 0.f, 0.f, 0.f};
#pragma unroll
        for (int ks = 0; ks < 2; ++ks) { const bf16x8 a = *(const LAS bf16x8*)(AB + (16 * mt + fr) * HPT + 32 * ks + 8 * Q); const bf16x8 b = *(const LAS bf16x8*)(VT + (16 * nt + fr) * HPT + 32 * ks + 8 * Q);
            acc = __builtin_amdgcn_mfma_f32_16x16x32_bf16(a, b, acc, 0, 0, 0); }
#pragma unroll
        for (int rg = 0; rg < 4; ++rg) ((bf16*)F.OI)[(size_t)(r0 + 16 * mt + 4 * Q + rg) * 512 + h * 128 + 16 * nt + fr] = (bf16)f2bf(acc[rg]); } }
    { const int mt = wave;
#pragma unroll
      for (int nt = 0; nt < 8; ++nt) { f32x4 acc = (f32x4){0.f, 0.f, 0.f, 0.f};
#pragma unroll
        for (int ks = 0; ks < 2; ++ks) { const bf16x8 a = *(const LAS bf16x8*)(KHT + (16 * mt + fr) * HPT + 32 * ks + 8 * Q); const bf16x8 b = *(const LAS bf16x8*)(VT + (16 * nt + fr) * HPT + 32 * ks + 8 * Q);
            acc = __builtin_amdgcn_mfma_f32_16x16x32_bf16(a, b, acc, 0, 0, 0); }
#pragma unroll
        for (int rg = 0; rg < 4; ++rg) ((bf16*)F.U)[((size_t)task * 128 + 16 * mt + 4 * Q + rg) * 128 + 16 * nt + fr] = (bf16)f2bf(acc[rg]); } }
    __syncthreads();
}
__device__ __forceinline__ void hgrn_scan(const Frame& F) {
    const int gt = F.vcu * NWAVES * 64 + F.tid, NGT = F.G * NWAVES * 64;
    for (int it = gt; it < 16 * 8192; it += NGT) {
        const int bh = it >> 13, e = it & 8191, k = e >> 6, v = (e & 63) * 2, b = bh >> 2, h = bh & 3;
        float s0 = 0.f, s1 = 0.f;
        float d[2][8]; unsigned uw[2][8];
#define HS_LOAD(s_, n0_) do { _Pragma("unroll") for (int j = 0; j < 8; ++j) { const int task = (b * 64 + (n0_) + j) * 4 + h; d[s_][j] = F.DEC[(size_t)task * 128 + k]; uw[s_][j] = *(const unsigned*)((const bf16*)F.U + ((size_t)task * 128 + k) * 128 + v); } } while (0)
#define HS_STEP(s_, n0_) do { _Pragma("unroll") for (int j = 0; j < 8; ++j) { const int task = (b * 64 + (n0_) + j) * 4 + h; *(unsigned*)(F.SP + ((size_t)task * 128 + k) * 128 + v) = pkbf(s0, s1); \
        s0 = d[s_][j] * s0 + bflo(uw[s_][j]); s1 = d[s_][j] * s1 + bfhi(uw[s_][j]); } } while (0)
        HS_LOAD(0, 0);
#pragma unroll 1
        for (int n0 = 0; n0 < 64; n0 += 16) { HS_LOAD(1, n0 + 8); HS_STEP(0, n0); if (n0 + 16 < 64) HS_LOAD(0, n0 + 16); HS_STEP(1, n0 + 8); }
#undef HS_LOAD
#undef HS_STEP
        *(f32x2*)(F.out + O_HP + ((size_t)bh * 128 + k) * 128 + v) = (f32x2){s0, s1};
    }
}
constexpr int HC_ST = 0, HC_OL = 34816, OLP = 132;
__device__ __forceinline__ void hgrn_c_task(const Frame& F, int task) {
    const int tid = F.tid, lane = F.lane, wave = F.wave;
    const int h = task & 3, bn = task >> 2, r0 = bn * 64;
    LAS bf16* ST = (LAS bf16*)(F.lds + HC_ST); LAS float* OL = (LAS float*)(F.lds + HC_OL);
    { unsigned w[16];
#pragma unroll
      for (int i = 0; i < 16; ++i) { const int e = tid + 512 * i, k = e >> 6, v = (e & 63) * 2; w[i] = *(const unsigned*)(F.SP + ((size_t)task * 128 + k) * 128 + v); }
#pragma unroll
      for (int i = 0; i < 16; ++i) { const int e = tid + 512 * i, k = e >> 6, v = (e & 63) * 2; ST[v * HP + k] = (bf16)(w[i] & 0xffffu); ST[(v + 1) * HP + k] = (bf16)(w[i] >> 16); } }
    __syncthreads();
    const int fr = lane & 15, Q = lane >> 4, mt = wave >> 1;
#pragma unroll
    for (int q = 0; q < 4; ++q) { const int nt = 4 * (wave & 1) + q; f32x4 acc = (f32x4){0.f, 0.f, 0.f, 0.f};
#pragma unroll
        for (int ks = 0; ks < 4; ++ks) { const bf16x8 a = *(const bf16x8*)(F.QI + (size_t)(r0 + 16 * mt + fr) * 512 + h * 128 + 32 * ks + 8 * Q); const bf16x8 b = *(const LAS bf16x8*)(ST + (16 * nt + fr) * HP + 32 * ks + 8 * Q);
            acc = __builtin_amdgcn_mfma_f32_16x16x32_bf16(a, b, acc, 0, 0, 0); }
#pragma unroll
        for (int rg = 0; rg < 4; ++rg) { const int t = 16 * mt + 4 * Q + rg, v = 16 * nt + fr; OL[t * OLP + v] = acc[rg] + bf2f(((const bf16*)F.OI)[(size_t)(r0 + t) * 512 + h * 128 + v]); } }
    __syncthreads();
    { bf16 gz[8][2]; const float g0 = F.hgrn_g[lane], g1 = F.hgrn_g[64 + lane];
#pragma unroll
      for (int i = 0; i < 8; ++i) { const bf16* z = F.Z + (size_t)(r0 + wave * 8 + i) * DINP + ZGB + h * 128; gz[i][0] = z[lane]; gz[i][1] = z[64 + lane]; }
#pragma unroll
      for (int i = 0; i < 8; ++i) { const int t = wave * 8 + i; const float x0 = OL[t * OLP + lane], x1 = OL[t * OLP + 64 + lane];
        const float rs = rsqrtf(wave_sum(x0 * x0 + x1 * x1) * (1.f / 128.f) + EPS);
        bf16* ob = F.OB + (size_t)(r0 + t) * 512 + h * 128;
        ob[lane] = (bf16)f2bf(x0 * rs * g0 * silu(bf2f(gz[i][0])));
        ob[64 + lane] = (bf16)f2bf(x1 * rs * g1 * silu(bf2f(gz[i][1]))); } }
    __syncthreads();
}
__device__ __forceinline__ void hgrn_sample_task(const Frame& F, int task) {
    const int tid = F.tid, b = task >> 2, h = task & 3, v = tid & 127, kq = tid >> 7;
    LAS float* fL = (LAS float*)F.lds; LAS float* kL = fL + 128; LAS float* qL = fL + 256; LAS float* vL = fL + 384; LAS float* red = fL + 512;
    float S[32];
    const float* s0 = F.st_hgrn + ((size_t)(b * 4 + h) * 128 + kq * 32) * 128 + v;
#pragma unroll
    for (int i = 0; i < 32; ++i) S[i] = s0[(size_t)i * 128];
    bf16 zf[TS], zq[TS], zi[TS];
    if (tid < 128) {
#pragma unroll
        for (int t = 0; t < TS; ++t) { const bf16* z = F.Z + (size_t)(MP + b * TS + t) * DINP + h * 128; zf[t] = z[ZFB + tid]; zq[t] = z[ZQB + tid]; zi[t] = z[ZIB + tid]; } }
    const float lbk = F.LB[h * 128 + (tid & 127)];
#pragma unroll
    for (int t = 0; t < TS; ++t) {
        const int r = MP + b * TS + t; const bf16* z = F.Z + (size_t)r * DINP + h * 128;
        if (tid < 128) { const float fz = bf2f(zf[t]);
            fL[tid] = lbk + (1.f - lbk) * sigm(fz); kL[tid] = (1.f - lbk) * sigm(-fz); qL[tid] = silu(bf2f(zq[t])); vL[tid] = bf2f(zi[t]); }
        __syncthreads();
        const float vv = vL[v]; float part = 0.f;
#pragma unroll
        for (int i = 0; i < 32; ++i) { const int kk = kq * 32 + i; S[i] = fL[kk] * S[i] + kL[kk] * vv; part += qL[kk] * S[i]; }
        red[kq * 128 + v] = part;
        __syncthreads();
        if (tid < 64) { const float o0 = (red[tid] + red[128 + tid]) + (red[256 + tid] + red[384 + tid]); const float o1 = (red[64 + tid] + red[192 + tid]) + (red[320 + tid] + red[448 + tid]);
            const float rs = rsqrtf(wave_sum(o0 * o0 + o1 * o1) * (1.f / 128.f) + EPS);
            bf16* ob = F.OB + (size_t)r * 512 + h * 128;
            ob[tid] = (bf16)f2bf(o0 * rs * F.hgrn_g[tid] * silu(bf2f(z[ZGB + tid])));
            ob[64 + tid] = (bf16)f2bf(o1 * rs * F.hgrn_g[64 + tid] * silu(bf2f(z[ZGB + 64 + tid]))); }
        __syncthreads();
    }
    float* so = F.out + O_HS + ((size_t)(b * 4 + h) * 128 + kq * 32) * 128 + v;
#pragma unroll
    for (int i = 0; i < 32; ++i) so[(size_t)i * 128] = S[i];
}

__device__ __forceinline__ void p10_fix(const Frame& F) {
    const int gt = F.vcu * NWAVES * 64 + F.tid, NGT = F.G * NWAVES * 64;
    constexpr int CG4 = DFF / 4;
    const f32x4 z4 = (f32x4){0.f, 0.f, 0.f, 0.f};
    for (int it = gt; it < 576 * CG4; it += NGT) {
        const int idx = it / CG4, c = (it % CG4) * 4;
        const f32x4 a0 = *(const f32x4*)(F.RAW + (size_t)idx * 2 * DFF + c), bb = *(const f32x4*)(F.RAW + ((size_t)idx * 2 + 1) * DFF + c);
        f32x4 a1, a2; int r;
        if (idx < 512) { const int k = idx >> 1, i = idx & 1; r = 64 * k + i; const bool first = (k & 63) == 0;
            const f32x4 h0 = first ? z4 : *(const f32x4*)(F.HALO + (size_t)(2 * (k - 1)) * DFF + c), h1 = first ? z4 : *(const f32x4*)(F.HALO + (size_t)(2 * (k - 1) + 1) * DFF + c);
            if (i == 0) { a1 = h1; a2 = h0; } else { a1 = *(const f32x4*)(F.RAW + (size_t)(idx - 1) * 2 * DFF + c); a2 = h1; } }
        else { const int s = (idx - 512) >> 1, i = idx & 1; r = MP + TS * s + i;
            const f32x4 c0 = *(const f32x4*)(F.st_conv + ((size_t)s * 2) * DFF + c), c1 = *(const f32x4*)(F.st_conv + ((size_t)s * 2 + 1) * DFF + c);
            if (i == 0) { a1 = c1; a2 = c0; } else { a1 = *(const f32x4*)(F.RAW + (size_t)(idx - 1) * 2 * DFF + c); a2 = c1; } }
        const f32x4 cb = *(const f32x4*)(F.conv_b + c), w0 = *(const f32x4*)(F.conv_w + c), w1 = *(const f32x4*)(F.conv_w + DFF + c), w2 = *(const f32x4*)(F.conv_w + 2 * DFF + c);
        f32x4 g;
#pragma unroll
        for (int j = 0; j < 4; ++j) { const float cv = cb[j] + w0[j] * a2[j] + w1[j] * a1[j] + w2[j] * a0[j]; g[j] = silu(cv) * bb[j]; }
        v2u w; w.x = pkbf(g[0], g[1]); w.y = pkbf(g[2], g[3]); *(v2u*)(F.GB + (size_t)r * DFF + c) = w;
    }
    for (int it = gt; it < (NBAT * 2 + DECB * 2) * CG4; it += NGT) { const int q = it / CG4, c = (it % CG4) * 4;
        if (q < NBAT * 2) { const int bq = q >> 1, i = q & 1; *(f32x4*)(F.out + O_FCP + (size_t)q * DFF + c) = *(const f32x4*)(F.HALO + (size_t)(2 * (64 * bq + 63) + i) * DFF + c); }
        else { const int q2 = q - NBAT * 2; *(f32x4*)(F.out + O_FCS + (size_t)q2 * DFF + c) = *(const f32x4*)(F.HALO + (size_t)(512 + q2) * DFF + c); } }
}

__device__ __forceinline__ int cg2_addr(int row, int c) { return row * 2048 + ((c ^ (row & 15)) << 4); }
__device__ __forceinline__ void cmp_gemm_wg2(const Frame& F, int task, const int tid, const int lane, const int wave) {
    const int b = task >> 4, j = (task >> 3) & 1, eighth = task & 7, Q = lane >> 4, fr = lane & 15;
    LAS unsigned char* As = F.lds;
    bf16x8 Bf[32];
    { const bf16* wp = F.W1T + (size_t)(j * 128 + 16 * wave + fr) * 1024 + 8 * Q;
#pragma unroll
      for (int ks = 0; ks < 32; ++ks) Bf[ks] = *(const bf16x8*)(wp + 32 * ks); }
    const int p32 = tid & 31, rin = tid >> 5, gst = p32 >> 4;
    const unsigned loff = (unsigned)(j * 128 + 4 * p32 + rin * 256) * 4u;
    const char* cbase = (const char*)F.cache_cmp;
    const int ptv = F.ptab[b * NPG + eighth * 16 + (lane & 15)];
    const int wofs = rin * 8 + ((p32 & 15) >> 1), wsub = (p32 & 1) * 8;
    f32x4 st[2][8];
#define CG2_LOAD(g_, q_) do { const int pg = __builtin_amdgcn_readlane(ptv, (g_)); const char* ub__ = cbase + (size_t)pg * (PAGE * 1024); \
        _Pragma("unroll") for (int i = 0; i < 8; ++i) st[q_][i] = *(const f32x4*)(ub__ + i * 16384 + loff); } while (0)
#define CG2_WRITE(buf_, q_) do { _Pragma("unroll") for (int i = 0; i < 8; ++i) { v2u w; w.x = pkbf(st[q_][i].x, st[q_][i].y); w.y = pkbf(st[q_][i].z, st[q_][i].w); \
        *(LAS v2u*)(As + (buf_) * 32768 + cg2_addr(gst * 8 + i, wofs) + wsub) = w; } } while (0)
    CG2_LOAD(0, 0); CG2_LOAD(1, 1); CG2_WRITE(0, 0);
    asm volatile("s_waitcnt lgkmcnt(0)" ::: "memory"); __builtin_amdgcn_s_barrier(); asm volatile("" ::: "memory");
    CG2_LOAD(2, 0);
    float* pb = F.PBUF + ((size_t)(j * 2 + (Q >> 1)) * CROWS + crow_base(NBAT + b) + eighth * 128 + 4 * (Q & 1)) * 128 + 16 * wave + fr;
#define CG2_BODY(g, q_) do { \
        f32x4 acc = (f32x4){0.f, 0.f, 0.f, 0.f}; \
        const LAS unsigned char* ab = As + (q_) * 32768 + fr * 2048 + ((Q ^ (fr & 3)) << 4); \
        f32x4 acc1 = (f32x4){0.f, 0.f, 0.f, 0.f}; \
        _Pragma("unroll") \
        for (int ks = 0; ks < 32; ks += 2) { const bf16x8 A0 = *(const LAS bf16x8*)(ab + (((4 * ks) ^ (fr & 12)) << 4)), A1 = *(const LAS bf16x8*)(ab + (((4 * (ks + 1)) ^ (fr & 12)) << 4)); \
            acc = __builtin_amdgcn_mfma_f32_16x16x32_bf16(A0, Bf[ks], acc, 0, 0, 0); acc1 = __builtin_amdgcn_mfma_f32_16x16x32_bf16(A1, Bf[ks + 1], acc1, 0, 0, 0); } \
        acc = acc + acc1; \
        _Pragma("unroll") \
        for (int rg = 0; rg < 4; ++rg) pb[(size_t)((g) * 8 + rg) * 128] = acc[rg]; \
        if ((g) + 1 < 16) CG2_WRITE(1 - (q_), 1 - (q_)); \
        asm volatile("s_waitcnt lgkmcnt(0)" ::: "memory"); __builtin_amdgcn_s_barrier(); asm volatile("" ::: "memory"); \
        if ((g) + 3 < 16) CG2_LOAD((g) + 3, 1 - (q_)); } while (0)
#pragma unroll 1
    for (int g = 0; g < 16; g += 2) { CG2_BODY(g, 0); CG2_BODY(g + 1, 1); }
#undef CG2_BODY
#undef CG2_LOAD
#undef CG2_WRITE
}

constexpr float NEG_BIG = -1e30f, M_INIT = -1e20f;
__device__ __forceinline__ float qmax4(float v) { const auto a = __builtin_amdgcn_permlane16_swap(__float_as_uint(v), __float_as_uint(v), false, false); v = fmaxf(__uint_as_float(a[0]), __uint_as_float(a[1]));
    const auto b = __builtin_amdgcn_permlane32_swap(__float_as_uint(v), __float_as_uint(v), false, false); return fmaxf(__uint_as_float(b[0]), __uint_as_float(b[1])); }
__device__ __forceinline__ float qsum4(float v) { const auto a = __builtin_amdgcn_permlane16_swap(__float_as_uint(v), __float_as_uint(v), false, false); v = __uint_as_float(a[0]) + __uint_as_float(a[1]);
    const auto b = __builtin_amdgcn_permlane32_swap(__float_as_uint(v), __float_as_uint(v), false, false); return __uint_as_float(b[0]) + __uint_as_float(b[1]); }

__device__ __forceinline__ void nsa_batch(const char* kbase, const char* vbase, int stride, int koff, int voff, int f32src, int kidx, bool valid, const float (&q)[4], bool do_pv,
                                          float (&m)[4], float (&l)[4], float (&acc)[4], f32x4& pv, LAS f32x4* wl_p, LAS int* wl_idx, int lane) {
    float vv[64];
    if (do_pv) {
        if (!f32src) { const bf16* vb = (const bf16*)vbase + voff + lane;
#pragma unroll
            for (int jj = 0; jj < 64; ++jj) vv[jj] = bf2f(vb[(size_t)__builtin_amdgcn_readlane(kidx, jj) * stride]); }
        else { const float* vb = (const float*)vbase + voff + lane;
#pragma unroll
            for (int jj = 0; jj < 64; ++jj) vv[jj] = vb[(size_t)__builtin_amdgcn_readlane(kidx, jj) * stride]; }
    }
    float sc[4] = {0.f, 0.f, 0.f, 0.f};
    if (!f32src) { const v4u* kp = (const v4u*)(kbase + ((size_t)kidx * stride + koff) * 2);
#pragma unroll
        for (int c8 = 0; c8 < 8; ++c8) { const v4u w = kp[c8]; const float kv[8] = {bflo(w.x), bfhi(w.x), bflo(w.y), bfhi(w.y), bflo(w.z), bfhi(w.z), bflo(w.w), bfhi(w.w)};
#pragma unroll
            for (int e = 0; e < 8; ++e)
#pragma unroll
                for (int hh = 0; hh < 4; ++hh) sc[hh] += __int_as_float(__builtin_amdgcn_readlane(__float_as_int(q[hh]), c8 * 8 + e)) * kv[e]; } }
    else { const f32x4* kp = (const f32x4*)(kbase + ((size_t)kidx * stride + koff) * 4);
#pragma unroll
        for (int c4 = 0; c4 < 16; ++c4) { const f32x4 w = kp[c4];
#pragma unroll
            for (int e = 0; e < 4; ++e)
#pragma unroll
                for (int hh = 0; hh < 4; ++hh) sc[hh] += __int_as_float(__builtin_amdgcn_readlane(__float_as_int(q[hh]), c4 * 4 + e)) * w[e]; } }
#pragma unroll
    for (int hh = 0; hh < 4; ++hh) { const float sv = valid ? sc[hh] : -1e30f; const float mn = fmaxf(m[hh], wave_max(sv));
        const float p = valid ? ex2(sv - mn) : 0.f; const float al = ex2(m[hh] - mn);
        l[hh] = l[hh] * al + wave_sum(p); acc[hh] *= al; m[hh] = mn; pv[hh] = p; }
    if (do_pv) {
#pragma unroll
        for (int jj = 0; jj < 64; ++jj) {
#pragma unroll
            for (int hh = 0; hh < 4; ++hh) acc[hh] += __int_as_float(__builtin_amdgcn_readlane(__float_as_int(pv[hh]), jj)) * vv[jj]; }
    }
}
constexpr int SL_A = 0, SL_E = 272, SL_SC = 544, SL_SEL = 816, SL_WM = 832, SL_WL = 928, SL_WACC = 1024, SL_PW = 1024 + 6144, SL_END = SL_PW + 8 * 320;
constexpr int SW_MX = 832, SW_LS = 960, SW_OP = 1088, SW_PT = SW_OP + 8 * 256, SW_END = SW_PT + 128;
__device__ __forceinline__ void nsa_sample_wg(const Frame& F, const int tid, const int lane, const int wave, int r, int g, LAS float* L) {
    const int rr = r - MP, bsm = rr / TS, t = rr - bsm * TS;
    const int* pt = F.ptab + bsm * NPG;
    const int fr = lane & 15, Q = lane >> 4, hq = fr & 3;
    bf16x8 qf[2];
#pragma unroll
    for (int ks = 0; ks < 2; ++ks) qf[ks] = *(const bf16x8*)(F.QR + (size_t)r * 512 + (g * 4 + hq) * 64 + 32 * ks + 8 * Q);
    float g0 = 0.f, g1 = 0.f, g2 = 0.f, oc_ = 0.f, ow_ = 0.f;
    if (tid < 256) { const int hh = tid >> 6, d = tid & 63; const float* gp_ = F.GATES + (size_t)r * 24 + (g * 4 + hh) * 3; g0 = gp_[0]; g1 = gp_[1]; g2 = gp_[2];
        oc_ = F.OCS[(size_t)rr * 512 + (g * 4 + hh) * 64 + d]; ow_ = F.OWS[(size_t)rr * 512 + (g * 4 + hh) * 64 + d]; }
    if (tid >= 384) ((LAS int*)(L + SW_PT))[tid - 384] = pt[tid - 384];
    if (tid < 260) { const int s = tid; const float im = F.IMPS[((size_t)rr * 2 + g) * 272 + (s < 257 ? s : 256)];
        L[SL_SC + s] = s >= 257 ? -3e38f : (((s == 0) | (s >= 255)) ? 1e4f : im); }
    __syncthreads();
    if (tid < 257) { const int s = tid; const float my = L[SL_SC + s]; int cnt = 0;
        for (int s4 = 0; s4 < 65; ++s4) { const f32x4 o = *(LAS f32x4*)(L + SL_SC + 4 * s4);
#pragma unroll
            for (int e = 0; e < 4; ++e) cnt += ((o[e] > my) | ((o[e] == my) & (4 * s4 + e < s))) ? 1 : 0; }
        if (cnt < 16) ((LAS int*)(L + SL_SEL))[cnt] = s; }
    __syncthreads();
    const int s0 = __builtin_amdgcn_readfirstlane(((LAS int*)(L + SL_SEL))[2 * wave]), s1 = __builtin_amdgcn_readfirstlane(((LAS int*)(L + SL_SEL))[2 * wave + 1]);
    f32x4 S[2][2][2];
#pragma unroll
    for (int kb = 0; kb < 2; ++kb) { const int s = kb ? s1 : s0;
        if (s < 256) { const float* base = F.cache_slc + ((size_t)__builtin_amdgcn_readfirstlane(((LAS int*)(L + SW_PT))[s >> 1]) * PAGE + (s & 1) * 64) * 256 + g * 64 + 8 * Q;
#pragma unroll
            for (int hf = 0; hf < 2; ++hf)
#pragma unroll
                for (int sub = 0; sub < 2; ++sub) { const f32x4* kp = (const f32x4*)(base + (size_t)(32 * hf + 16 * sub + fr) * 256); const f32x4 a0 = kp[0], a1 = kp[1], b0 = kp[8], b1 = kp[9];
                    v4u w0, w1; w0.x = pkbf(a0.x, a0.y); w0.y = pkbf(a0.z, a0.w); w0.z = pkbf(a1.x, a1.y); w0.w = pkbf(a1.z, a1.w); w1.x = pkbf(b0.x, b0.y); w1.y = pkbf(b0.z, b0.w); w1.z = pkbf(b1.x, b1.y); w1.w = pkbf(b1.z, b1.w);
                    f32x4 a = (f32x4){0.f, 0.f, 0.f, 0.f}; a = __builtin_amdgcn_mfma_f32_16x16x32_bf16(__builtin_bit_cast(bf16x8, w0), qf[0], a, 0, 0, 0); a = __builtin_amdgcn_mfma_f32_16x16x32_bf16(__builtin_bit_cast(bf16x8, w1), qf[1], a, 0, 0, 0);
                    S[kb][hf][sub] = a; } }
        else {
#pragma unroll
            for (int hf = 0; hf < 2; ++hf)
#pragma unroll
                for (int sub = 0; sub < 2; ++sub) { const int jn = 32 * hf + 16 * sub + fr; const bf16* kp = F.KVS + (size_t)(MP + bsm * TS + (jn < TS ? jn : TS - 1)) * 256 + g * 64 + 8 * Q;
                    f32x4 a = (f32x4){0.f, 0.f, 0.f, 0.f}; a = __builtin_amdgcn_mfma_f32_16x16x32_bf16(*(const bf16x8*)kp, qf[0], a, 0, 0, 0); a = __builtin_amdgcn_mfma_f32_16x16x32_bf16(*(const bf16x8*)(kp + 32), qf[1], a, 0, 0, 0);
#pragma unroll
                    for (int rg = 0; rg < 4; ++rg) a[rg] = (32 * hf + 16 * sub + 4 * Q + rg <= t) ? a[rg] : NEG_BIG;
                    S[kb][hf][sub] = a; } } }
    float vr[2][2][4][8];
#pragma unroll
    for (int kb = 0; kb < 2; ++kb) { const int s = kb ? s1 : s0;
        if (s < 256) { const float* base = F.cache_slc + ((size_t)__builtin_amdgcn_readfirstlane(((LAS int*)(L + SW_PT))[s >> 1]) * PAGE + (s & 1) * 64) * 256 + 128 + g * 64 + fr;
#pragma unroll
            for (int hf = 0; hf < 2; ++hf)
#pragma unroll
                for (int dt = 0; dt < 4; ++dt)
#pragma unroll
                    for (int i = 0; i < 8; ++i) vr[kb][hf][dt][i] = base[(size_t)(32 * hf + (i >> 2) * 16 + 4 * Q + (i & 3)) * 256 + 16 * dt]; }
        else {
#pragma unroll
            for (int hf = 0; hf < 2; ++hf)
#pragma unroll
                for (int dt = 0; dt < 4; ++dt)
#pragma unroll
                    for (int i = 0; i < 8; ++i) { const int kk = 32 * hf + (i >> 2) * 16 + 4 * Q + (i & 3); vr[kb][hf][dt][i] = bf2f(F.KVS[(size_t)(MP + bsm * TS + (kk < TS ? kk : TS - 1)) * 256 + 128 + g * 64 + 16 * dt + fr]); } } }
    { float m_ = M_INIT;
#pragma unroll
        for (int kb = 0; kb < 2; ++kb)
#pragma unroll
            for (int hf = 0; hf < 2; ++hf)
#pragma unroll
                for (int sub = 0; sub < 2; ++sub)
#pragma unroll
                    for (int rg = 0; rg < 4; ++rg) m_ = fmaxf(m_, S[kb][hf][sub][rg]);
        m_ = qmax4(m_); float l_ = 0.f;
#pragma unroll
        for (int kb = 0; kb < 2; ++kb)
#pragma unroll
            for (int hf = 0; hf < 2; ++hf)
#pragma unroll
                for (int sub = 0; sub < 2; ++sub)
#pragma unroll
                    for (int rg = 0; rg < 4; ++rg) l_ += ex2(S[kb][hf][sub][rg] - m_);
        l_ = qsum4(l_);
        if (Q == 0) { L[SW_MX + wave * 16 + fr] = m_; L[SW_LS + wave * 16 + fr] = l_; } }
    __syncthreads();
    float Mx = M_INIT;
#pragma unroll
    for (int w = 0; w < 8; ++w) Mx = fmaxf(Mx, L[SW_MX + w * 16 + fr]);
    f32x4 O[4];
#pragma unroll
    for (int dt = 0; dt < 4; ++dt) O[dt] = (f32x4){0.f, 0.f, 0.f, 0.f};
#pragma unroll
    for (int kb = 0; kb < 2; ++kb)
#pragma unroll
        for (int hf = 0; hf < 2; ++hf) { float p[2][4];
#pragma unroll
            for (int sub = 0; sub < 2; ++sub)
#pragma unroll
                for (int rg = 0; rg < 4; ++rg) p[sub][rg] = ex2(S[kb][hf][sub][rg] - Mx);
            v4u w; w.x = pkbf(p[0][0], p[0][1]); w.y = pkbf(p[0][2], p[0][3]); w.z = pkbf(p[1][0], p[1][1]); w.w = pkbf(p[1][2], p[1][3]); const bf16x8 pf = __builtin_bit_cast(bf16x8, w);
#pragma unroll
            for (int dt = 0; dt < 4; ++dt) { const float (&v8)[8] = vr[kb][hf][dt];
                v4u u; u.x = pkbf(v8[0], v8[1]); u.y = pkbf(v8[2], v8[3]); u.z = pkbf(v8[4], v8[5]); u.w = pkbf(v8[6], v8[7]);
                O[dt] = __builtin_amdgcn_mfma_f32_16x16x32_bf16(__builtin_bit_cast(bf16x8, u), pf, O[dt], 0, 0, 0); } }
    if (fr < 4) {
#pragma unroll
        for (int dt = 0; dt < 4; ++dt)
#pragma unroll
            for (int rg = 0; rg < 4; ++rg) L[SW_OP + wave * 256 + (16 * dt + 4 * Q + rg) * 4 + fr] = O[dt][rg]; }
    __syncthreads();
    if (tid < 256) { const int hh = tid >> 6, d = tid & 63; float M = M_INIT;
#pragma unroll
        for (int w = 0; w < 8; ++w) M = fmaxf(M, L[SW_MX + w * 16 + hh]);
        float Ls = 0.f, ob = 0.f;
#pragma unroll
        for (int w = 0; w < 8; ++w) { Ls += L[SW_LS + w * 16 + hh] * ex2(L[SW_MX + w * 16 + hh] - M); ob += L[SW_OP + w * 256 + d * 4 + hh]; }
        const float o = g0 * oc_ + g1 * ob / fmaxf(Ls, 1e-30f) + g2 * ow_;
        F.OA[(size_t)r * 512 + (g * 4 + hh) * 64 + d] = (bf16)f2bf(o); }
    __syncthreads();
}

constexpr int SC_WMX = 0, SC_WLS = 256, SC_MT = 512, SC_LT = 544, SC_A = 576, SC_E = SC_A + 8 * 272, SC_OP = SC_E + 8 * 272, SC_END = SC_OP + 8 * 2048;
__device__ __forceinline__ void nsa_sample_cmp(const Frame& F, int b, int g, const int tid, const int lane, const int wave, LAS float* L) {
    const int fr = lane & 15, Q = lane >> 4, tok = fr & 7, hsel = fr >> 3, crb = crow_base(NBAT + b), kb0 = 128 * wave;
    bf16x8 qf[2][2];
#pragma unroll
    for (int j = 0; j < 2; ++j)
#pragma unroll
        for (int ks = 0; ks < 2; ++ks) qf[j][ks] = *(const bf16x8*)(F.QR + (size_t)(MP + b * TS + tok) * 512 + (g * 4 + 2 * j + hsel) * 64 + 32 * ks + 8 * Q);
    const bf16* kp = F.KC + ((size_t)g * CROWS + crb + kb0 + fr) * 64 + 8 * Q;
    f32x4 S[4][2][2];
#pragma unroll
    for (int st = 0; st < 4; ++st)
#pragma unroll
        for (int sub = 0; sub < 2; ++sub) { const bf16x8 k0 = *(const bf16x8*)(kp + (size_t)(st * 32 + sub * 16) * 64), k1 = *(const bf16x8*)(kp + (size_t)(st * 32 + sub * 16) * 64 + 32);
#pragma unroll
            for (int j = 0; j < 2; ++j) { f32x4 a = (f32x4){0.f, 0.f, 0.f, 0.f}; a = __builtin_amdgcn_mfma_f32_16x16x32_bf16(k0, qf[j][0], a, 0, 0, 0); a = __builtin_amdgcn_mfma_f32_16x16x32_bf16(k1, qf[j][1], a, 0, 0, 0);
#pragma unroll
                for (int rg = 0; rg < 4; ++rg) if (kb0 + st * 32 + sub * 16 + 4 * Q + rg > 1022) a[rg] = NEG_BIG;
                S[st][sub][j] = a; } }
    float mx[2], ls[2];
#pragma unroll
    for (int j = 0; j < 2; ++j) { float m_ = NEG_BIG;
#pragma unroll
        for (int st = 0; st < 4; ++st)
#pragma unroll
            for (int sub = 0; sub < 2; ++sub)
#pragma unroll
                for (int rg = 0; rg < 4; ++rg) m_ = fmaxf(m_, S[st][sub][j][rg]);
        m_ = qmax4(m_); float l_ = 0.f;
#pragma unroll
        for (int st = 0; st < 4; ++st)
#pragma unroll
            for (int sub = 0; sub < 2; ++sub)
#pragma unroll
                for (int rg = 0; rg < 4; ++rg) l_ += ex2(S[st][sub][j][rg] - m_);
        l_ = qsum4(l_); mx[j] = m_; ls[j] = l_;
        if (Q == 0) { L[SC_WMX + (wave * 2 + j) * 16 + fr] = m_; L[SC_WLS + (wave * 2 + j) * 16 + fr] = l_; } }
    __syncthreads();
    float M[2], invl[2];
#pragma unroll
    for (int j = 0; j < 2; ++j) { float m_ = NEG_BIG;
#pragma unroll
        for (int w = 0; w < 8; ++w) m_ = fmaxf(m_, L[SC_WMX + (w * 2 + j) * 16 + fr]);
        float l_ = 0.f;
#pragma unroll
        for (int w = 0; w < 8; ++w) l_ += L[SC_WLS + (w * 2 + j) * 16 + fr] * ex2(L[SC_WMX + (w * 2 + j) * 16 + fr] - m_);
        M[j] = m_; invl[j] = 1.f / fmaxf(l_, 1e-30f);
        if (wave == 0 && Q == 0) L[SC_LT + j * 16 + fr] = invl[j]; }
    f32x4 O[2][4];
#pragma unroll
    for (int j = 0; j < 2; ++j)
#pragma unroll
        for (int dt = 0; dt < 4; ++dt) O[j][dt] = (f32x4){0.f, 0.f, 0.f, 0.f};
    const bf16* vp = F.VCT + ((size_t)g * 64 + fr) * CROWS + crb + kb0 + 4 * Q;
#pragma unroll
    for (int st = 0; st < 4; ++st) { bf16x8 pf[2]; float p[2][2][4];
#pragma unroll
        for (int j = 0; j < 2; ++j) {
#pragma unroll
            for (int sub = 0; sub < 2; ++sub)
#pragma unroll
                for (int rg = 0; rg < 4; ++rg) p[j][sub][rg] = ex2(S[st][sub][j][rg] - M[j]);
            v4u w; w.x = pkbf(p[j][0][0], p[j][0][1]); w.y = pkbf(p[j][0][2], p[j][0][3]); w.z = pkbf(p[j][1][0], p[j][1][1]); w.w = pkbf(p[j][1][2], p[j][1][3]); pf[j] = __builtin_bit_cast(bf16x8, w); }
#pragma unroll
        for (int sub = 0; sub < 2; ++sub) { float a = 0.f, e = 0.f;
#pragma unroll
            for (int j = 0; j < 2; ++j) { a += ((p[j][sub][0] + p[j][sub][1]) + (p[j][sub][2] + p[j][sub][3])) * invl[j]; e += p[j][sub][3] * invl[j]; }
            a += __shfl_xor(a, 8); e += __shfl_xor(e, 8);
            const int s_ = (kb0 + 32 * st + 16 * sub) / 4 + Q;
            if (hsel == 0) { L[SC_A + tok * 272 + s_] = a; L[SC_E + tok * 272 + s_] = e; } }
#pragma unroll
        for (int dt = 0; dt < 4; ++dt) { const v2u lo = *(const v2u*)(vp + (size_t)dt * 16 * CROWS + st * 32), hi = *(const v2u*)(vp + (size_t)dt * 16 * CROWS + st * 32 + 16);
            v4u w; w.x = lo.x; w.y = lo.y; w.z = hi.x; w.w = hi.y; const bf16x8 vf = __builtin_bit_cast(bf16x8, w);
#pragma unroll
            for (int j = 0; j < 2; ++j) O[j][dt] = __builtin_amdgcn_mfma_f32_16x16x32_bf16(vf, pf[j], O[j][dt], 0, 0, 0); } }
#pragma unroll
    for (int j = 0; j < 2; ++j)
#pragma unroll
        for (int dt = 0; dt < 4; ++dt)
#pragma unroll
            for (int rg = 0; rg < 4; ++rg) L[SC_OP + wave * 2048 + (16 * dt + 4 * Q + rg) * 32 + 16 * j + fr] = O[j][dt][rg];
    __syncthreads();
#pragma unroll
    for (int i = 0; i < 4; ++i) { const int idx = tid + 512 * i, d = idx >> 5, col = idx & 31; float o = 0.f;
#pragma unroll
        for (int w = 0; w < 8; ++w) o += L[SC_OP + w * 2048 + idx];
        const int tk = col & 7, hd = 2 * (col >> 4) + ((col >> 3) & 1);
        F.OCS[(size_t)(b * TS + tk) * 512 + (g * 4 + hd) * 64 + d] = o * L[SC_LT + col]; }
    for (int i = tid; i < 8 * 257; i += NWAVES * 64) { const int tk = i / 257, s_ = i % 257;
        F.IMPS[((size_t)(b * TS + tk) * 2 + g) * 272 + s_] = (s_ < 256 ? L[SC_A + tk * 272 + s_] : 0.f) + (s_ > 0 ? L[SC_E + tk * 272 + s_ - 1] : 0.f); }
    __syncthreads();
}

__device__ __forceinline__ void nsa_sample_win(const Frame& F, int b, int g, const int tid, const int lane, const int wave, LAS float* L) {
    const int fr = lane & 15, Q = lane >> 4, tok = fr & 7, hsel = fr >> 3;
    bf16x8 qf[2][2];
#pragma unroll
    for (int j = 0; j < 2; ++j)
#pragma unroll
        for (int ks = 0; ks < 2; ++ks) qf[j][ks] = *(const bf16x8*)(F.QR + (size_t)(MP + b * TS + tok) * 512 + (g * 4 + 2 * j + hsel) * 64 + 32 * ks + 8 * Q);
    const float* swb = F.st_win + (size_t)b * 512 * 256;
    f32x4 S[3][2][2];
#pragma unroll
    for (int k = 0; k < 3; ++k) { const int st = wave + 8 * k;
#pragma unroll
        for (int sub = 0; sub < 2; ++sub)
#pragma unroll
            for (int j = 0; j < 2; ++j) S[k][sub][j] = (f32x4){NEG_BIG, NEG_BIG, NEG_BIG, NEG_BIG};
        if (st < 17) {
#pragma unroll
            for (int sub = 0; sub < 2; ++sub) { bf16x8 k0, k1;
                if (st < 16) { const f32x4* kp = (const f32x4*)(swb + (size_t)(32 * st + 16 * sub + fr) * 256 + g * 64 + 8 * Q); const f32x4 a0 = kp[0], a1 = kp[1], b0 = kp[8], b1 = kp[9];
                    v4u w0, w1; w0.x = pkbf(a0.x, a0.y); w0.y = pkbf(a0.z, a0.w); w0.z = pkbf(a1.x, a1.y); w0.w = pkbf(a1.z, a1.w); w1.x = pkbf(b0.x, b0.y); w1.y = pkbf(b0.z, b0.w); w1.z = pkbf(b1.x, b1.y); w1.w = pkbf(b1.z, b1.w);
                    k0 = __builtin_bit_cast(bf16x8, w0); k1 = __builtin_bit_cast(bf16x8, w1); }
                else { const int jn = 16 * sub + fr; const bf16* kp = F.KVW + (size_t)(MP + b * TS + (jn < TS ? jn : TS - 1)) * 256 + g * 64 + 8 * Q; k0 = *(const bf16x8*)kp; k1 = *(const bf16x8*)(kp + 32); }
#pragma unroll
                for (int j = 0; j < 2; ++j) { f32x4 a = (f32x4){0.f, 0.f, 0.f, 0.f}; a = __builtin_amdgcn_mfma_f32_16x16x32_bf16(k0, qf[j][0], a, 0, 0, 0); a = __builtin_amdgcn_mfma_f32_16x16x32_bf16(k1, qf[j][1], a, 0, 0, 0);
#pragma unroll
                    for (int rg = 0; rg < 4; ++rg) { const int kk = 16 * sub + 4 * Q + rg; const bool ok = st < 16 ? (32 * st + kk >= tok + 1) : (kk <= tok); a[rg] = ok ? a[rg] : NEG_BIG; }
                    S[k][sub][j] = a; } } } }
    float Mx[2], invl[2];
#pragma unroll
    for (int j = 0; j < 2; ++j) { float m_ = NEG_BIG;
#pragma unroll
        for (int k = 0; k < 3; ++k)
#pragma unroll
            for (int sub = 0; sub < 2; ++sub)
#pragma unroll
                for (int rg = 0; rg < 4; ++rg) m_ = fmaxf(m_, S[k][sub][j][rg]);
        m_ = fmaxf(qmax4(m_), M_INIT); float l_ = 0.f;
#pragma unroll
        for (int k = 0; k < 3; ++k)
#pragma unroll
            for (int sub = 0; sub < 2; ++sub)
#pragma unroll
                for (int rg = 0; rg < 4; ++rg) l_ += ex2(S[k][sub][j][rg] - m_);
        l_ = qsum4(l_);
        if (Q == 0) { L[SC_WMX + (wave * 2 + j) * 16 + fr] = m_; L[SC_WLS + (wave * 2 + j) * 16 + fr] = l_; } }
    __syncthreads();
#pragma unroll
    for (int j = 0; j < 2; ++j) { float m_ = M_INIT;
#pragma unroll
        for (int w = 0; w < 8; ++w) m_ = fmaxf(m_, L[SC_WMX + (w * 2 + j) * 16 + fr]);
        float l_ = 0.f;
#pragma unroll
        for (int w = 0; w < 8; ++w) l_ += L[SC_WLS + (w * 2 + j) * 16 + fr] * ex2(L[SC_WMX + (w * 2 + j) * 16 + fr] - m_);
        Mx[j] = m_; invl[j] = 1.f / fmaxf(l_, 1e-30f);
        if (wave == 0 && Q == 0) L[SC_LT + j * 16 + fr] = invl[j]; }
    f32x4 O[2][4];
#pragma unroll
    for (int j = 0; j < 2; ++j)
#pragma unroll
        for (int dt = 0; dt < 4; ++dt) O[j][dt] = (f32x4){0.f, 0.f, 0.f, 0.f};
#pragma unroll
    for (int k = 0; k < 3; ++k) { const int st = wave + 8 * k;
        if (st < 17) { bf16x8 pf[2];
#pragma unroll
            for (int j = 0; j < 2; ++j) { float p[2][4];
#pragma unroll
                for (int sub = 0; sub < 2; ++sub)
#pragma unroll
                    for (int rg = 0; rg < 4; ++rg) p[sub][rg] = ex2(S[k][sub][j][rg] - Mx[j]);
                v4u w; w.x = pkbf(p[0][0], p[0][1]); w.y = pkbf(p[0][2], p[0][3]); w.z = pkbf(p[1][0], p[1][1]); w.w = pkbf(p[1][2], p[1][3]); pf[j] = __builtin_bit_cast(bf16x8, w); }
#pragma unroll
            for (int dt = 0; dt < 4; ++dt) { float v8[8];
#pragma unroll
                for (int i = 0; i < 8; ++i) { const int kk = (i >> 2) * 16 + 4 * Q + (i & 3);
                    if (st < 16) v8[i] = swb[(size_t)(32 * st + kk) * 256 + 128 + g * 64 + 16 * dt + fr];
                    else v8[i] = bf2f(F.KVW[(size_t)(MP + b * TS + (kk < TS ? kk : TS - 1)) * 256 + 128 + g * 64 + 16 * dt + fr]); }
                v4u w; w.x = pkbf(v8[0], v8[1]); w.y = pkbf(v8[2], v8[3]); w.z = pkbf(v8[4], v8[5]); w.w = pkbf(v8[6], v8[7]); const bf16x8 vf = __builtin_bit_cast(bf16x8, w);
#pragma unroll
                for (int j = 0; j < 2; ++j) O[j][dt] = __builtin_amdgcn_mfma_f32_16x16x32_bf16(vf, pf[j], O[j][dt], 0, 0, 0); } } }
#pragma unroll
    for (int j = 0; j < 2; ++j)
#pragma unroll
        for (int dt = 0; dt < 4; ++dt)
#pragma unroll
            for (int rg = 0; rg < 4; ++rg) L[SC_OP + wave * 2048 + (16 * dt + 4 * Q + rg) * 32 + 16 * j + fr] = O[j][dt][rg];
    __syncthreads();
#pragma unroll
    for (int i = 0; i < 4; ++i) { const int idx = tid + 512 * i, d = idx >> 5, col = idx & 31; float o = 0.f;
#pragma unroll
        for (int w = 0; w < 8; ++w) o += L[SC_OP + w * 2048 + idx];
        const int tk = col & 7, hd = 2 * (col >> 4) + ((col >> 3) & 1);
        F.OWS[(size_t)(b * TS + tk) * 512 + (g * 4 + hd) * 64 + d] = o * L[SC_LT + col]; }
    __syncthreads();
}

constexpr int NW_KBUF = 0, NW_VBUF = 16384, NW_UNI = 32768, NW_OACC = 33024, NW_END = NW_OACC + 65536;
static_assert(NW_END <= 131072, "nsa_wg LDS map");
__device__ __forceinline__ int nw_kaddr(int key, int c) { return (key >> 1) * 256 + ((((key & 1) * 8 + c) ^ ((key >> 1) & 15)) * 16); }
__device__ __forceinline__ int nw_vaddr(int d, int q) { return d * 64 + ((q ^ ((d >> 2) & 3)) * 16); }
struct NwStage { const bf16* src0; int mul; int w0, w1; bool kthr; };
struct NwReg { v4u a, b; };
__device__ __forceinline__ void nw_load(NwReg& r, const NwStage& st, int kb) { r.a = *(const v4u*)(st.src0 + (size_t)kb * st.mul); r.b = *(const v4u*)(st.src0 + (size_t)(kb + 32) * st.mul); }
__device__ __forceinline__ void nw_write(LAS unsigned char* L, int buf, const NwStage& st, const NwReg& r) {
    if (st.kthr) { *(LAS v4u*)(L + NW_KBUF + buf * 8192 + st.w0) = r.a; *(LAS v4u*)(L + NW_KBUF + buf * 8192 + 4096 + st.w0) = r.b; }
    else { *(LAS v2u*)(L + NW_VBUF + buf * 8192 + st.w0) = (v2u){r.a.x, r.a.y}; *(LAS v2u*)(L + NW_VBUF + buf * 8192 + st.w1) = (v2u){r.a.z, r.a.w};
           *(LAS v2u*)(L + NW_VBUF + buf * 8192 + 4096 + st.w0) = (v2u){r.b.x, r.b.y}; *(LAS v2u*)(L + NW_VBUF + buf * 8192 + 4096 + st.w1) = (v2u){r.b.z, r.b.w}; }
}
#define NW_BAR() do { asm volatile("s_waitcnt lgkmcnt(0)" ::: "memory"); __builtin_amdgcn_s_barrier(); asm volatile("" ::: "memory"); } while (0)
template <int MODE, int VAR>
__device__ __forceinline__ void nw_compute(LAS unsigned char* L, int buf, int kb0_, unsigned long long selm, int t, int tlast, int cvis,
                                           const bf16x8 (&qf)[2][2], const int (&kro)[2][2], const int (&vro)[4], float (&m)[2], float (&l)[2], f32x4 (&O)[2][4],
                                           const float (&invl)[2], LAS float* impw, float& eprev, int fr, int Q, int lane) {
#pragma unroll
      for (int hs = 0; hs < 2; ++hs) { const int kbh = kb0_ + 32 * hs;
        const bool active = MODE == 0 ? (kbh <= (tlast - 31) >> 4) : (kbh <= tlast);
        if (active) { const int kb = kbh;
            const LAS unsigned char* kbp = L + NW_KBUF + buf * 8192 + hs * 4096; const LAS unsigned char* vbp = L + NW_VBUF + buf * 8192 + hs * 4096;
            f32x4 S[2][2];
            __builtin_amdgcn_s_setprio(1);
#pragma unroll
            for (int sub = 0; sub < 2; ++sub) { const bf16x8 k0 = *(const LAS bf16x8*)(kbp + kro[sub][0]), k1 = *(const LAS bf16x8*)(kbp + kro[sub][1]);
#pragma unroll
                for (int h = 0; h < 2; ++h) { const float ini = (MODE != 0 && VAR == 0) ? -m[h] : 0.f; f32x4 a = (f32x4){ini, ini, ini, ini}; a = __builtin_amdgcn_mfma_f32_16x16x32_bf16(k0, qf[h][0], a, 0, 0, 0); a = __builtin_amdgcn_mfma_f32_16x16x32_bf16(k1, qf[h][1], a, 0, 0, 0); S[sub][h] = a; } }
            __builtin_amdgcn_s_setprio(0);
            const bool mine = MODE == 1 ? (bool)((selm >> (kb >> 6)) & 1ull) : true;
            const int tfirst = tlast - 15;
            const bool nomask = MODE == 0 ? (kb + 31 <= (tfirst - 31) >> 4) : (MODE == 1 ? (__all(mine) && kb + 31 <= tfirst) : (kb + 31 <= tfirst && kb + 512 > tlast));
            if (!nomask) {
#pragma unroll
            for (int sub = 0; sub < 2; ++sub)
#pragma unroll
                for (int rg = 0; rg < 4; ++rg) { const int kp = kb + sub * 16 + 4 * Q + rg;
                    const bool ok = MODE == 0 ? (kp <= cvis) : (MODE == 1 ? (mine & (kp <= t)) : ((kp <= t) & (kp + 512 > t)));
#pragma unroll
                    for (int h = 0; h < 2; ++h) S[sub][h][rg] = ok ? S[sub][h][rg] : NEG_BIG; }
            }
            if (VAR == 0) {
                bf16x8 pf[2];
#pragma unroll
                for (int h = 0; h < 2; ++h) { const f32x4 a = S[0][h], b = S[1][h];
                    float mn;
                    if (MODE == 0) { const float mx = qmax4(fmaxf(fmaxf(fmaxf(a[0], a[1]), fmaxf(a[2], a[3])), fmaxf(fmaxf(b[0], b[1]), fmaxf(b[2], b[3]))));
                        mn = fmaxf(m[h], mx); const float al = ex2(m[h] - mn); m[h] = mn; l[h] *= al;
#pragma unroll
                        for (int dt = 0; dt < 4; ++dt) O[h][dt] = O[h][dt] * al; }
                    else mn = 0.f;
                    const float p0 = ex2(a[0] - mn), p1 = ex2(a[1] - mn), p2 = ex2(a[2] - mn), p3 = ex2(a[3] - mn), p4 = ex2(b[0] - mn), p5 = ex2(b[1] - mn), p6 = ex2(b[2] - mn), p7 = ex2(b[3] - mn);
                    l[h] += ((p0 + p1) + (p2 + p3)) + ((p4 + p5) + (p6 + p7));
                    v4u w; w.x = pkbf(p0, p1); w.y = pkbf(p2, p3); w.z = pkbf(p4, p5); w.w = pkbf(p6, p7); pf[h] = __builtin_bit_cast(bf16x8, w); }
                __builtin_amdgcn_s_setprio(1);
#pragma unroll
                for (int dt = 0; dt < 4; ++dt) { const bf16x8 vf = *(const LAS bf16x8*)(vbp + vro[dt]);
#pragma unroll
                    for (int h = 0; h < 2; ++h) O[h][dt] = __builtin_amdgcn_mfma_f32_16x16x32_bf16(vf, pf[h], O[h][dt], 0, 0, 0); }
                __builtin_amdgcn_s_setprio(0);
            } else {
#pragma unroll
                for (int sub = 0; sub < 2; ++sub) { float a = 0.f, e = 0.f;
#pragma unroll
                    for (int rg = 0; rg < 4; ++rg)
#pragma unroll
                        for (int h = 0; h < 2; ++h) { const float pn = ex2(S[sub][h][rg] - m[h]) * invl[h]; a += pn; if (rg == 3) e += pn; }
                    const float up1 = __shfl(e, (lane + 48) & 63), up0 = __shfl(eprev, (lane + 48) & 63);
                    const int s = (kb >> 2) + sub * 4 + Q;
                    impw[fr * 64 + ((s + fr) & 63)] = a + (Q == 0 ? up0 : up1);
                    eprev = e; }
            }
        }
      }
}
template <int MODE, int VAR>
__device__ __forceinline__ void nw_run(LAS unsigned char* L, const NwStage& st, int kb0, int lim, unsigned long long U, unsigned long long selm, int t, int tlast, int cvis,
                                       const bf16x8 (&qf)[2][2], const int (&kro)[2][2], const int (&vro)[4], float (&m)[2], float (&l)[2], f32x4 (&O)[2][4],
                                       const float (&invl)[2], LAS float* impw, int fr, int Q, int lane) {
    if (kb0 > lim) return;
    NwReg r0, r1; nw_load(r0, st, kb0); r1 = r0;
    nw_write(L, 0, st, r0);
    NW_BAR();
    float eprev = 0.f;
    int buf = 0, kb = kb0, kb1 = kb0 + 64;
    if (MODE == 1) { while (kb1 <= lim && !((U >> (kb1 >> 6)) & 1ull)) kb1 += 64; }
    if (kb1 <= lim) nw_load(r0, st, kb1);
#define NW_STEP(RW, RL) { \
        int kb2 = kb1 + 64; \
        if (MODE == 1) { while (kb2 <= lim && !((U >> (kb2 >> 6)) & 1ull)) kb2 += 64; } \
        if (kb2 <= lim) nw_load(RL, st, kb2); \
        nw_compute<MODE, VAR>(L, buf, kb, selm, t, tlast, cvis, qf, kro, vro, m, l, O, invl, impw, eprev, fr, Q, lane); \
        if (kb1 <= lim) nw_write(L, buf ^ 1, st, RW); \
        NW_BAR(); \
        buf ^= 1; kb = kb1; kb1 = kb2; }
#pragma unroll 1
    for (;;) { NW_STEP(r0, r1) if (kb > lim) break; NW_STEP(r1, r0) if (kb > lim) break; }
#undef NW_STEP
}
template <bool FIRST> __device__ __forceinline__ void nw_finish(LAS float* wo, int lane, const float* gp, int br, float mreset, float (&m)[2], float (&l)[2], f32x4 (&O)[2][4]) {
#pragma unroll
    for (int h = 0; h < 2; ++h) { const float sc = gp[h * 3 + br] / fmaxf(qsum4(l[h]), 1e-30f);
#pragma unroll
        for (int dt = 0; dt < 4; ++dt)
#pragma unroll
            for (int rg = 0; rg < 4; ++rg) { volatile LAS float* p = wo + ((h * 4 + dt) * 4 + rg) * 64 + lane; const float v = O[h][dt][rg] * sc; *p = FIRST ? v : *p + v; }
        m[h] = mreset; l[h] = 0.f;
#pragma unroll
        for (int dt = 0; dt < 4; ++dt) O[h][dt] = (f32x4){0.f, 0.f, 0.f, 0.f}; }
}
__device__ __forceinline__ void nsa_wg_tile(const Frame& F, const int tid, const int lane, const int wave, int b, int g, int tile, LAS unsigned char* L) {
    const int fr = lane & 15, Q = lane >> 4, tg = wave >> 1, hp = wave & 1;
    const int T0 = tile * 64, t0 = T0 + 16 * tg, t = t0 + fr, tlast = t0 + 15, cur = tile;
    const size_t row0 = (size_t)b * SEQ; const int crb = b * NCH_P;
    bf16x8 qf[2][2];
#pragma unroll
    for (int h = 0; h < 2; ++h)
#pragma unroll
        for (int ks = 0; ks < 2; ++ks) qf[h][ks] = *(const bf16x8*)(F.QR + (row0 + t) * 512 + (g * 4 + 2 * hp + h) * 64 + 32 * ks + 8 * Q);
    const float* gp = F.GATES + (row0 + t) * 24 + (g * 4 + 2 * hp) * 3;
    int kro[2][2], vro[4];
#pragma unroll
    for (int sub = 0; sub < 2; ++sub)
#pragma unroll
        for (int ks = 0; ks < 2; ++ks) kro[sub][ks] = nw_kaddr(16 * sub + fr, 4 * ks + Q);
#pragma unroll
    for (int dt = 0; dt < 4; ++dt) vro[dt] = nw_vaddr(16 * dt + fr, Q);
    NwStage sC, sS, sW; const bool kthr = tid < 256; const int sk = tid >> 3, sc8 = tid & 7, sd = (tid & 255) >> 2, sp = tid & 3;
    sC.kthr = sS.kthr = sW.kthr = kthr;
    sC.w0 = sS.w0 = sW.w0 = kthr ? nw_kaddr(sk, sc8) : nw_vaddr(sd, 2 * (sp & 1)) + 8 * (sp >> 1);
    sC.w1 = sS.w1 = sW.w1 = nw_vaddr(sd, 2 * (sp & 1) + 1) + 8 * (sp >> 1);
    if (kthr) { sC.src0 = F.KC + ((size_t)g * CROWS + crb + sk) * 64 + 8 * sc8; sC.mul = 64;
                sS.src0 = F.KVS + (row0 + sk) * 256 + g * 64 + 8 * sc8; sS.mul = 256; sW.src0 = F.KVW + (row0 + sk) * 256 + g * 64 + 8 * sc8; sW.mul = 256; }
    else { sC.src0 = F.VCT + ((size_t)g * 64 + sd) * CROWS + crb + 8 * sp; sC.mul = 1;
           sS.src0 = F.VTS + ((size_t)(b * 2 + g) * 64 + sd) * SEQ + 8 * sp; sS.mul = 1; sW.src0 = F.VTW + ((size_t)(b * 2 + g) * 64 + sd) * SEQ + 8 * sp; sW.mul = 1; }
    LAS float* wo = (LAS float*)(L + NW_OACC + wave * 8192);
    LAS float* impw = (LAS float*)(L + NW_OACC + wave * 8192);
    float m[2] = {M_INIT, M_INIT}, l[2] = {0.f, 0.f}, invl[2] = {0.f, 0.f};
    f32x4 O[2][4];
#pragma unroll
    for (int h = 0; h < 2; ++h)
#pragma unroll
        for (int dt = 0; dt < 4; ++dt) O[h][dt] = (f32x4){0.f, 0.f, 0.f, 0.f};
    const int cvis = (t - 31) >> 4;
    const int clim = ((T0 + 63 - 31) >> 4) & ~63;
    nw_run<0, 0>(L, sC, 0, clim, 0ull, 0ull, t, tlast, cvis, qf, kro, vro, m, l, O, invl, impw, fr, Q, lane);
    unsigned long long selmask = ~0ull;
    if (cur >= 16) {
#pragma unroll
        for (int h = 0; h < 2; ++h) invl[h] = 1.f / fmaxf(qsum4(l[h]), 1e-30f);
        float mk[2] = {m[0], m[1]};
        nw_run<0, 1>(L, sC, 0, clim, 0ull, 0ull, t, tlast, cvis, qf, kro, vro, mk, l, O, invl, impw, fr, Q, lane);
        const LAS float* i0 = (const LAS float*)(L + NW_OACC + (tg * 2) * 8192); const LAS float* i1 = i0 + 2048;
        unsigned bits = 0;
#pragma unroll 1
        for (int half = 0; half < 2; ++half) {
            float my[8]; int cnt[8];
#pragma unroll
            for (int i = 0; i < 8; ++i) { const int s = 16 * Q + 8 * half + i; const bool forced = (s == 0) | (s == cur) | (s == cur - 1); const int a = fr * 64 + ((s + fr) & 63);
                my[i] = forced ? 1e4f : (s <= cur ? i0[a] + i1[a] : -1.f); cnt[i] = 0; }
#pragma unroll 1
            for (int s2 = 0; s2 <= cur; ++s2) { const bool forced2 = (s2 == 0) | (s2 >= cur - 1); const int a = fr * 64 + ((s2 + fr) & 63); const float o = forced2 ? 1e4f : i0[a] + i1[a];
#pragma unroll
                for (int i = 0; i < 8; ++i) cnt[i] += ((o > my[i]) | ((o == my[i]) & (s2 < 16 * Q + 8 * half + i))) ? 1 : 0; }
#pragma unroll
            for (int i = 0; i < 8; ++i) bits |= (cnt[i] < 16 ? 1u : 0u) << (8 * half + i);
        }
        unsigned lo = Q == 0 ? bits : (Q == 1 ? bits << 16 : 0u), hi = Q == 2 ? bits : (Q == 3 ? bits << 16 : 0u);
        lo |= __shfl_xor(lo, 16); lo |= __shfl_xor(lo, 32); hi |= __shfl_xor(hi, 16); hi |= __shfl_xor(hi, 32);
        selmask = ((unsigned long long)hi << 32) | lo;
    }
    unsigned ulo = (unsigned)selmask, uhi = (unsigned)(selmask >> 32);
#pragma unroll
    for (int o = 1; o < 16; o <<= 1) { ulo |= __shfl_xor(ulo, o); uhi |= __shfl_xor(uhi, o); }
    if (lane == 0) { ((LAS unsigned*)(L + NW_UNI))[wave * 2] = ulo; ((LAS unsigned*)(L + NW_UNI))[wave * 2 + 1] = uhi; }
    NW_BAR();
    unsigned long long U = 0ull;
#pragma unroll
    for (int w = 0; w < 8; ++w) U |= ((unsigned long long)((LAS unsigned*)(L + NW_UNI))[w * 2 + 1] << 32) | ((LAS unsigned*)(L + NW_UNI))[w * 2];
    U = ((unsigned long long)(unsigned)__builtin_amdgcn_readfirstlane((unsigned)(U >> 32)) << 32) | (unsigned)__builtin_amdgcn_readfirstlane((unsigned)U);
    const float m0 = F.M0[0];
    nw_finish<true>(wo, lane, gp, 0, m0, m, l, O);
    nw_run<1, 0>(L, sS, 0, T0 + 63, U, selmask, t, tlast, cvis, qf, kro, vro, m, l, O, invl, impw, fr, Q, lane);
    nw_finish<false>(wo, lane, gp, 1, m0, m, l, O);
    nw_run<2, 0>(L, sW, (T0 - 511 > 0 ? T0 - 511 : 0) & ~63, T0 + 63, 0ull, 0ull, t, tlast, cvis, qf, kro, vro, m, l, O, invl, impw, fr, Q, lane);
    nw_finish<false>(wo, lane, gp, 2, m0, m, l, O);
#pragma unroll
    for (int h = 0; h < 2; ++h)
#pragma unroll
        for (int dt = 0; dt < 4; ++dt) { volatile LAS float* p = wo + ((h * 4 + dt) * 4) * 64 + lane; v2u w; w.x = pk2(p[0], p[64]); w.y = pk2(p[128], p[192]);
            *(v2u*)(F.OA + (row0 + t) * 512 + (g * 4 + 2 * hp + h) * 64 + 16 * dt + 4 * Q) = w; }
    NW_BAR();
}

struct EpiSBranchA { float* T1; const bf16* Z; __device__ __forceinline__ void operator()(int row, int col, float v) const { T1[(size_t)row * DM + col] = sigm(bf2f(Z[(size_t)row * DINP + ZMG + col])) * v; } };
struct EpiSBranchB { const float* T1; bf16* MB; const bf16* Z; __device__ __forceinline__ void operator()(int row, int col, float v) const { MB[(size_t)row * DM + col] = (bf16)f2bf(T1[(size_t)row * DM + col] + sigm(bf2f(Z[(size_t)row * DINP + ZMG + DM + col])) * v); } };
struct EpiSRes { const float* base; float* out; __device__ __forceinline__ void operator()(int row, int col, float v) const { out[(size_t)row * DM + col] = base[(size_t)row * DM + col] + v; } };
template <int K, class EpiS> __device__ __forceinline__ void small_gemm(const Frame& F, const bf16* A, const bf16* Bt, const EpiS& E, const int tid, const int lane, const int wave) {
    constexpr int KW = K / 8;
    static_assert(KW % 32 == 0, "small_gemm: K/8 must be a multiple of 32");
    LAS float* red = (LAS float*)F.lds;
    const int fr = lane & 15, Q = lane >> 4;
    for (int task = F.vcu; task < 256; task += F.G) {
        const int rb = task >> 6, cb = task & 63;
        f32x4 acc[4];
#pragma unroll
        for (int mt = 0; mt < 4; ++mt) acc[mt] = (f32x4){0.f, 0.f, 0.f, 0.f};
        const bf16* ap = A + (size_t)(MP + 64 * rb + fr) * K + wave * KW + 8 * Q;
        const bf16* bp = Bt + (size_t)(16 * cb + fr) * K + wave * KW + 8 * Q;
#pragma unroll
        for (int ks = 0; ks < KW / 32; ++ks) { const bf16x8 B = *(const bf16x8*)(bp + 32 * ks);
#pragma unroll
            for (int mt = 0; mt < 4; ++mt) { const bf16x8 Af = *(const bf16x8*)(ap + (size_t)mt * 16 * K + 32 * ks); acc[mt] = __builtin_amdgcn_mfma_f32_16x16x32_bf16(Af, B, acc[mt], 0, 0, 0); } }
#pragma unroll
        for (int mt = 0; mt < 4; ++mt)
#pragma unroll
            for (int rg = 0; rg < 4; ++rg) red[(wave * 64 + 16 * mt + 4 * Q + rg) * 16 + fr] = acc[mt][rg];
        __syncthreads();
        for (int e = tid; e < 1024; e += NWAVES * 64) { float s = 0.f;
#pragma unroll
            for (int w = 0; w < 8; ++w) s += red[w * 1024 + e];
            E(MP + 64 * rb + (e >> 4), 16 * cb + (e & 15), s); }
        __syncthreads();
    }
}

__device__ __forceinline__ void small_gemm_rows(const Frame& F, const bf16* A, const bf16* Bt, const int tid, const int lane, const int wave) {
    constexpr int K = DM, KW = K / 8;
    LAS float* red = (LAS float*)F.lds;
    const int fr = lane & 15, Q = lane >> 4;
    for (int task = F.vcu; task < 256; task += F.G) {
        const int rb = task >> 4, cb = task & 15;
        f32x4 acc[4];
#pragma unroll
        for (int nt = 0; nt < 4; ++nt) acc[nt] = (f32x4){0.f, 0.f, 0.f, 0.f};
        const bf16* ap = A + (size_t)(MP + 16 * rb + fr) * K + wave * KW + 8 * Q;
        const bf16* bp = Bt + (size_t)(64 * cb + fr) * K + wave * KW + 8 * Q;
#pragma unroll
        for (int ks = 0; ks < KW / 32; ++ks) { const bf16x8 Af = *(const bf16x8*)(ap + 32 * ks);
#pragma unroll
            for (int nt = 0; nt < 4; ++nt) { const bf16x8 B = *(const bf16x8*)(bp + (size_t)nt * 16 * K + 32 * ks); acc[nt] = __builtin_amdgcn_mfma_f32_16x16x32_bf16(Af, B, acc[nt], 0, 0, 0); } }
#pragma unroll
        for (int nt = 0; nt < 4; ++nt)
#pragma unroll
            for (int rg = 0; rg < 4; ++rg) red[(wave * 16 + 4 * Q + rg) * 64 + 16 * nt + fr] = acc[nt][rg];
        __syncthreads();
#pragma unroll
        for (int i = 0; i < 2; ++i) { const int e = tid + i * NWAVES * 64, row = e >> 6, col = e & 63; float s = 0.f;
#pragma unroll
            for (int w = 0; w < 8; ++w) s += red[w * 1024 + e];
            const int grow = MP + 16 * rb + row, gcol = 64 * cb + col;
            const float x1 = F.xs[(size_t)(grow - MP) * DM + gcol] + s; F.X1[(size_t)grow * DM + gcol] = x1; F.H[(size_t)grow * DM + gcol] = (bf16)f2bf(x1 * F.ffn_g[gcol]);
            const float ss = wave_sum(x1 * x1); if (lane == 0) F.SSP[(size_t)grow * 16 + cb] = ss; }
        __syncthreads();
    }
}

#ifndef MK_ONE_LAUNCH
#define MK_ONE_LAUNCH 0
#endif
constexpr int N_PHASES = 12;
struct Args { const float* in[24]; float* out; unsigned char* ws; int ph_lo, ph_hi; };
__global__ void __launch_bounds__(NWAVES * 64, 2) fwd(Args args) {
    extern __shared__ __attribute__((aligned(16))) unsigned char lds[];
    Frame F;
    F.lds = (LAS unsigned char*)lds;
    F.tid = threadIdx.x; F.lane = F.tid & 63; F.wave = __builtin_amdgcn_readfirstlane(F.tid >> 6);
    F.G = gridDim.x; { const int bx = blockIdx.x; F.vcu = (F.G % 8 == 0) ? (bx % 8) * (F.G / 8) + bx / 8 : bx; }
    unsigned char* ws = args.ws;
    F.xp = args.in[0]; F.xs = args.in[1]; F.cache_cmp = args.in[2]; F.cache_slc = args.in[3]; F.ptab = (const int*)args.in[4]; F.st_win = args.in[5]; F.st_hgrn = args.in[6]; F.st_conv = args.in[7];
    F.attn_g = args.in[8]; F.w_in = args.in[9]; F.q_g = args.in[10]; F.k_g = args.in[11]; F.pos_emb = args.in[12]; F.cmp_w1 = args.in[13]; F.cmp_w2 = args.in[14]; F.lb_logits = args.in[15];
    F.hgrn_g = args.in[16]; F.w_branch = args.in[17]; F.w_out = args.in[18]; F.ffn_g = args.in[19]; F.ffn_w_in = args.in[20]; F.conv_w = args.in[21]; F.conv_b = args.in[22]; F.ffn_w_out = args.in[23];
    F.out = args.out;
    F.WIN = (bf16*)(ws + WS_WIN); F.WBA = (bf16*)(ws + WS_WBA); F.WBB = (bf16*)(ws + WS_WBB); F.WOUT = (bf16*)(ws + WS_WOUT); F.WFIN = (bf16*)(ws + WS_WFIN); F.WFOUT = (bf16*)(ws + WS_WFOUT); F.W1T = (bf16*)(ws + WS_W1T);
    F.H = (bf16*)(ws + WS_H); F.Z = (bf16*)(ws + WS_Z); F.QR = (bf16*)(ws + WS_QR); F.KVC = (bf16*)(ws + WS_KVC); F.KVS = (bf16*)(ws + WS_KVS); F.KVW = (bf16*)(ws + WS_KVW);
    F.KC = (bf16*)(ws + WS_KC); F.VC = (bf16*)(ws + WS_VC); F.VCT = (bf16*)(ws + WS_VCT); F.VTS = (bf16*)(ws + WS_VTS); F.VTW = (bf16*)(ws + WS_VTW); F.SP = (bf16*)(ws + WS_SP); F.QI = (bf16*)(ws + WS_QI); F.OA = (bf16*)(ws + WS_OA); F.OB = (bf16*)(ws + WS_OB); F.MB = (bf16*)(ws + WS_MB); F.GB = (bf16*)(ws + WS_G);
    F.ROPE = (float*)(ws + WS_ROPE); F.LB = (float*)(ws + WS_LB); F.CBIAS = (float*)(ws + WS_CBIAS); F.M0 = (float*)(ws + WS_M0); F.RAW = (float*)(ws + WS_RAW); F.HALO = (float*)(ws + WS_HALO); F.SSP = (float*)(ws + WS_SSP); F.OCS = (float*)(ws + WS_OCS); F.IMPS = (float*)(ws + WS_IMPS); F.OWS = (float*)(ws + WS_OWS); F.GATES = (float*)(ws + WS_GATES); F.PBUF = (float*)(ws + WS_PBUF); F.U = (float*)(ws + WS_U); F.OI = (float*)(ws + WS_OI);
    F.DEC = (float*)(ws + WS_DEC); F.T1 = (float*)(ws + WS_T1); F.X1 = (float*)(ws + WS_X1);
    for (int u = F.tid; u < (LDS_BYTES - LDSCTL_OFF) / 4; u += NWAVES * 64) ((LAS unsigned*)(F.lds + LDSCTL_OFF))[u] = 0u;
    __syncthreads();
    volatile LAS unsigned* MISC = (volatile LAS unsigned*)(F.lds + MISC_OFF);
    unsigned* barw = (unsigned*)(ws + WS_CTL) + CW_BAR;
    XcdBarrier bar; bar.bar = barw; bar.x = 0; bar.st = nullptr;
    if (MK_ONE_LAUNCH) bar = xcd_barrier_post(barw, MISC + 8);
    const int lo = args.ph_lo, hi = args.ph_hi;
#define IN(k) (lo <= (k) && (k) < hi)
#ifndef DOUBLE_MASK
#define DOUBLE_MASK 0
#endif
#define XDONE_SIGNAL(n_) do { if (MK_ONE_LAUNCH) { asm volatile("s_waitcnt vmcnt(0)" ::: "memory"); __syncthreads(); \
    if (F.tid == 0) { __builtin_amdgcn_fence(__ATOMIC_RELEASE, "agent"); asm volatile("s_waitcnt vmcnt(0)" ::: "memory"); (void)xb_add(&barw[CW_XDONE - CW_BAR], (n_)); } } } while (0)
#define DBL(k) (((DOUBLE_MASK) >> (k)) & 1)
#define SEAM(k) do { if (MK_ONE_LAUNCH && IN(k) && IN((k) + 1)) { REFRESH(); xcd_barrier(bar, F.tid); if (DBL(20)) { REFRESH(); xcd_barrier(bar, F.tid); } } } while (0)
#define REFRESH() do { int l_ = (int)__builtin_amdgcn_mbcnt_hi(~0u, __builtin_amdgcn_mbcnt_lo(~0u, 0u)); asm volatile("" : "+v"(l_)); F.lane = l_; F.tid = F.wave * 64 + l_; } while (0)
    const int gw = F.vcu * NWAVES + F.wave, NGW = F.G * NWAVES;
    LAS unsigned char* ring = F.lds + RING_OFF;

    if (IN(0)) { for (int rep_ = 0; rep_ < 1 + DBL(0); ++rep_) { REFRESH(); p0_prologue(F); } SEAM(0); }
    if (IN(1)) { for (int rep_ = 0; rep_ < 1 + DBL(1); ++rep_) { REFRESH();
        pg8::Gemm g{F.H, F.WIN, MT, DINP, DM}; pg8::StaticOrder S; S.init(MT, DINP, F.G, (int)blockIdx.x);
        pg8::EpiBf16<0> E{F.Z, DINP, nullptr, 0, 0, 1.f};
        if (((F.vcu >> 5) & 1) == 0) { for (int r3_ = 0; r3_ < 1 + DBL(24); ++r3_) for (int task = F.vcu; task < 512; task += F.G) { REFRESH(); cmp_gemm_wg2(F, task, F.tid, F.lane, F.wave); } __syncthreads(); REFRESH(); }
        pg8::gemm_phase<pg8::EpiBf16<0>, pg8::StaticOrder, true, true>(ring, g, S, E, F.tid);
        if (((F.vcu >> 5) & 1) == 1) { __syncthreads(); for (int r3_ = 0; r3_ < 1 + DBL(24); ++r3_) for (int task = F.vcu; task < 512; task += F.G) { REFRESH(); cmp_gemm_wg2(F, task, F.tid, F.lane, F.wave); } __syncthreads(); }
        } SEAM(1);
    }
    if (IN(2)) { for (int rep_ = 0; rep_ < 1 + DBL(2); ++rep_) { REFRESH(); p2_features(F); } SEAM(2); }
    if (IN(3)) { for (int rep_ = 0; rep_ < 1 + DBL(3); ++rep_) { REFRESH();
        for (int r2_ = 0; r2_ < 1 + DBL(15); ++r2_) for (int task = F.vcu; task < 1024; task += F.G) { REFRESH(); hgrn_a_task(F, task); }
        REFRESH();
        for (int task = gw; task < 2048; task += NGW) cmp_gemm_task(F, task, F.lane);
        } SEAM(3);
    }
    if (IN(4)) { for (int rep_ = 0; rep_ < 1 + DBL(4); ++rep_) { REFRESH();
        for (int r2_ = 0; r2_ < 1 + DBL(17); ++r2_) hgrn_scan(F);
        for (int r2_ = 0; r2_ < 1 + DBL(18); ++r2_) { if (NGW == 2048) cmp_tail_mfma(F, gw, F.lane); else for (int run = gw; run < 128 + 4096; run += NGW) cmp_tail_run(F, run, F.lane); }
        } SEAM(4);
    }
    if (IN(5)) { for (int rep_ = 0; rep_ < 1 + DBL(5); ++rep_) { REFRESH();
        { const bool late_ = MK_ONE_LAUNCH && F.G == 256 && F.vcu >= 64 && (F.vcu & 1); const int grp_ = F.vcu & 1;
#pragma unroll 1
          for (int step_ = 0; step_ < 5; ++step_) {
            const int kind_ = !late_ ? (step_ == 0 ? 0 : (step_ == 1 ? 1 : (step_ == 2 ? (grp_ == 0 ? 3 : 4) : (step_ == 3 ? 2 : (grp_ == 1 ? 3 : 4)))))
                                     : (step_ == 0 ? 1 : (step_ == 1 ? 0 : (step_ == 2 ? 4 : (step_ == 3 ? 2 : 3))));
            if (kind_ == 0) {
            if (F.G == 256) {
                if (F.vcu < 64) { REFRESH(); nsa_sample_cmp(F, F.vcu >> 1, F.vcu & 1, F.tid, F.lane, F.wave, (LAS float*)ring); REFRESH(); nsa_sample_win(F, F.vcu >> 1, F.vcu & 1, F.tid, F.lane, F.wave, (LAS float*)ring); XDONE_SIGNAL(1u); }
                const int i_ = F.vcu - 64, nt_ = F.vcu < 64 ? 2 : (F.vcu < 128 ? 6 : 5);
                for (int k_ = 0; k_ < nt_; ++k_) { const int task = F.vcu < 64 ? F.vcu + 64 * k_ : (k_ < 5 ? 128 + i_ + 192 * k_ : 1088 + i_); REFRESH(); if (task < 1024) hgrn_c_task(F, task); else hgrn_sample_task(F, task - 1024); }
            } else {
                for (int id = F.vcu; id < 64; id += F.G) { REFRESH(); nsa_sample_cmp(F, id >> 1, id & 1, F.tid, F.lane, F.wave, (LAS float*)ring); REFRESH(); nsa_sample_win(F, id >> 1, id & 1, F.tid, F.lane, F.wave, (LAS float*)ring); XDONE_SIGNAL(1u); }
                for (int task = F.vcu; task < 1024 + 128; task += F.G) { REFRESH(); if (task < 1024) hgrn_c_task(F, task); else hgrn_sample_task(F, task - 1024); }
            }
            } else if (kind_ == 1 || kind_ == 2) {
                for (int task = F.vcu; task < 256; task += F.G) { const int bg = task >> 5, jj = task & 31;
                    REFRESH(); nsa_wg_tile(F, F.tid, F.lane, F.wave, bg >> 1, bg & 1, kind_ == 1 ? 63 - jj : jj, ring); }
            } else if (kind_ == 3) {
                if (MK_ONE_LAUNCH) { if (F.tid == 0) { XB_SPIN(xb_ld(&barw[CW_XDONE - CW_BAR]) < 64u, barw); __builtin_amdgcn_fence(__ATOMIC_ACQUIRE, "agent"); asm volatile("s_waitcnt vmcnt(0)" ::: "memory"); } __syncthreads(); }
                for (int id = F.vcu; id < 2 * MS; id += F.G) { REFRESH(); nsa_sample_wg(F, F.tid, F.lane, F.wave, MP + (id >> 1), id & 1, (LAS float*)ring); }
            }
            __syncthreads(); REFRESH(); } }
        } SEAM(5);
    }
    if (IN(6)) { for (int rep_ = 0; rep_ < 1 + DBL(6); ++rep_) { REFRESH();
        { const bool sf_ = MK_ONE_LAUNCH && (F.vcu & 1);
#pragma unroll 1
          for (int part_ = 0; part_ < 2; ++part_) {
            if ((part_ == 0) == sf_) { REFRESH();
                small_gemm<512>(F, F.OA, F.WBA, EpiSBranchA{F.T1, F.Z}, F.tid, F.lane, F.wave);
                small_gemm<512>(F, F.OB, F.WBB, EpiSBranchB{F.T1, F.MB, F.Z}, F.tid, F.lane, F.wave); }
            else {
                { pg8::Gemm g{F.OA, F.WBA, MP, DM, 512}; pg8::StaticOrder S; S.init(MP, DM, F.G, (int)blockIdx.x);
                  pg8::EpiBranch<0> E{(bf16*)F.T1, F.MB, F.Z, DINP, ZMG, DM};
                  pg8::gemm_phase<pg8::EpiBranch<0>, pg8::StaticOrder, true, true>(ring, g, S, E, F.tid); }
                { pg8::Gemm g{F.OB, F.WBB, MP, DM, 512}; pg8::StaticOrder S; S.init(MP, DM, F.G, (int)blockIdx.x);
                  pg8::EpiBranch<1> E{(bf16*)F.T1, F.MB, F.Z, DINP, ZMG + DM, DM};
                  pg8::gemm_phase<pg8::EpiBranch<1>, pg8::StaticOrder, true, true>(ring, g, S, E, F.tid); } }
            __syncthreads(); REFRESH(); } }
        } SEAM(6);
    }
    if (IN(7)) { for (int rep_ = 0; rep_ < 1 + DBL(7); ++rep_) { REFRESH();
        pg8::Gemm g{F.MB, F.WOUT, MP, DM, DM}; pg8::StaticOrder S; S.init(MP, DM, F.G, (int)blockIdx.x);
        pg8::EpiResNorm E{F.xp, F.X1, F.H, F.ffn_g, F.SSP, DM};
        { const bool sf_ = MK_ONE_LAUNCH && (F.vcu & 1);
#pragma unroll 1
          for (int part_ = 0; part_ < 2; ++part_) {
            if ((part_ == 0) == sf_) { REFRESH(); small_gemm_rows(F, F.MB, F.WOUT, F.tid, F.lane, F.wave); }
            else pg8::gemm_phase<pg8::EpiResNorm, pg8::StaticOrder, true, true>(ring, g, S, E, F.tid);
            __syncthreads(); REFRESH(); } }
        } if (MK_ONE_LAUNCH && IN(7) && IN(9)) { REFRESH(); xcd_barrier(bar, F.tid); }
    }
    if (IN(9)) { for (int rep_ = 0; rep_ < 1 + DBL(9); ++rep_) { REFRESH();
        pg8::Gemm g{F.H, F.WFIN, MT, DFF2, DM}; pg8::StaticOrder S; S.init(MT, DFF2, F.G, (int)blockIdx.x);
        LAS int* SLOT = (LAS int*)(F.lds + LDSCTL_OFF + 1024); LAS float* RSL = (LAS float*)(F.lds + LDSCTL_OFF + 2048); LAS float* CWL = (LAS float*)(F.lds + LDSCTL_OFF + 8192);
#pragma unroll
        for (int i = 0; i < 6; ++i) { int upm = 0, upn = 0; const bool has = pg8::static_unit(MT / 256, DFF2 / 256, F.G, (int)blockIdx.x, i, upm, upn);
            if (has && F.tid < 256) { const f32x4* sp = (const f32x4*)(F.SSP + ((size_t)upm * 256 + F.tid) * 16); const f32x4 s4 = (sp[0] + sp[1]) + (sp[2] + sp[3]);
                RSL[i * 256 + F.tid] = rsqrtf(((s4[0] + s4[1]) + (s4[2] + s4[3])) * (1.f / 1024.f) + EPS); }
            if (has) { const int q = F.tid >> 7, cc = F.tid & 127; CWL[i * 512 + q * 128 + cc] = q == 0 ? F.conv_b[upn * 128 + cc] : F.conv_w[(size_t)(q - 1) * DFF + upn * 128 + cc]; }
            if (has && F.tid == 0) { SLOT[upm] = i; SLOT[128 + upn] = i; } }
        __syncthreads();
        pg8::EpiFfn E{F.GB, RSL, SLOT, CWL, F.RAW, F.HALO, MP, DFF};
        pg8::gemm_phase<pg8::EpiFfn, pg8::StaticOrder, true, true>(ring, g, S, E, F.tid);
        } SEAM(9);
    }
    if (IN(10)) { for (int rep_ = 0; rep_ < 1 + DBL(10); ++rep_) { REFRESH(); p10_fix(F); } SEAM(10); }
    if (IN(11)) { for (int rep_ = 0; rep_ < 1 + DBL(11); ++rep_) { REFRESH();
        pg8::Gemm g{F.GB, F.WFOUT, MP, DM, DFF}; pg8::StaticOrder S; S.init(MP, DM, F.G, (int)blockIdx.x);
        pg8::EpiRes E{F.X1, F.X1 + (size_t)MP * DM, F.out + O_YP, DM, MP};
        { const bool sf_ = MK_ONE_LAUNCH && (F.vcu & 1);
#pragma unroll 1
          for (int part_ = 0; part_ < 2; ++part_) {
            if ((part_ == 0) == sf_) { REFRESH(); small_gemm<DFF>(F, F.GB, F.WFOUT, EpiSRes{F.X1, F.out + O_YP}, F.tid, F.lane, F.wave); }
            else pg8::gemm_phase<pg8::EpiRes, pg8::StaticOrder, true, true>(ring, g, S, E, F.tid);
            __syncthreads(); REFRESH(); } }
    } }
#undef IN
#undef SEAM
#undef REFRESH
}

extern "C" void kernel_launch(void* const* d_in, const int* in_sizes, int n_in, void* d_out, int out_size, void* d_ws, size_t ws_size, hipStream_t stream) {
    static int grid = 0;
    if (grid == 0) {
        if (n_in != 24 || out_size != (int)O_END || ws_size < WS_END) { fprintf(stderr, "kernel_launch: unexpected sizes n_in %d out %d ws %zu\n", n_in, out_size, ws_size); grid = -1; return; }
        int dev = 0, cus = 0;
        if (hipGetDevice(&dev) != hipSuccess || hipDeviceGetAttribute(&cus, hipDeviceAttributeMultiprocessorCount, dev) != hipSuccess) { grid = -1; return; }
        if (hipFuncSetAttribute((const void*)fwd, hipFuncAttributeMaxDynamicSharedMemorySize, LDS_BYTES) != hipSuccess) { fprintf(stderr, "kernel_launch: hipFuncSetAttribute failed\n"); grid = -1; return; }
        int per_cu = 0;
        if (hipOccupancyMaxActiveBlocksPerMultiprocessor(&per_cu, (const void*)fwd, NWAVES * 64, LDS_BYTES) != hipSuccess || per_cu < 1) fprintf(stderr, "kernel_launch: occupancy query says %d\n", per_cu);
        (void)hipGetLastError();
        grid = cus;
    }
    if (grid < 0) return;
    (void)hipMemsetAsync((char*)d_ws + WS_CTL, 0, CTL_ZERO_BYTES, stream);
    Args a{};
    for (int i = 0; i < 24; ++i) a.in[i] = (const float*)d_in[i];
    a.out = (float*)d_out; a.ws = (unsigned char*)d_ws;
#if MK_ONE_LAUNCH
    a.ph_lo = 0; a.ph_hi = N_PHASES;
    hipLaunchKernelGGL(fwd, dim3(grid), dim3(NWAVES * 64), LDS_BYTES, stream, a);
#else
    for (int ph = 0; ph < N_PHASES; ++ph) { a.ph_lo = ph; a.ph_hi = ph + 1; hipLaunchKernelGGL(fwd, dim3(grid), dim3(NWAVES * 64), LDS_BYTES, stream, a); }
#endif
}
```

```cpp
#include <hip/hip_runtime.h>
#include <cstdio>
#include <cstdint>
#define MK_ONE_LAUNCH 1
namespace pg8 {
#define PG8_LAS __attribute__((address_space(3)))
typedef unsigned short bf16_t;
typedef short bf16x8 __attribute__((ext_vector_type(8)));
typedef float f32x4 __attribute__((ext_vector_type(4)));
typedef unsigned u32x4 __attribute__((ext_vector_type(4)));
constexpr int BM = 256, BK = 64, HALF = 128, HTB = HALF * BK * 2  , STAGE_BYTES = 8 * HTB, NXCD = 8, WGM = 8;

__host__ __device__ __forceinline__ int lds_byte(int r, int c) { const int st = (r >> 4) * 2 + (c >> 5), rr = r & 15, cc = c & 31, ob = rr * 64 + cc * 2; return st * 1024 + (ob ^ (((ob >> 9) & 1) << 5)); }
__host__ __device__ __forceinline__ void stage_rc(int b, int& R, int& C) { const int st = b / 1024, sb = b % 1024, swz = sb ^ (((sb >> 9) & 1) << 5); R = (st >> 1) * 16 + swz / 64; C = (st & 1) * 32 + (swz % 64) / 2; }
__host__ __device__ __forceinline__ int perm32(int rho) { const int n = rho >> 4, i = rho & 15; return 8 * (i >> 2) + 4 * n + (i & 3); }

struct Unit { int pm, pn; };
struct Gemm { const bf16_t* A; const bf16_t* Bt; int M, N, K; };

struct StaticOrder {
    int nM, nN, nwg, G, c;
    __host__ __device__ void init(int M, int N, int G_, int c_) { nM = M / BM; nN = N / BM; nwg = nM * nN; G = G_; c = c_; }
    __host__ __device__ bool next(int i, Unit& u) const {
        const long L = (long)i * G + c; if (L >= nwg) return false;
        int wgid = (int)L; { const int q = nwg / NXCD, r = nwg % NXCD, xcd = wgid % NXCD, off = wgid / NXCD; wgid = (xcd < r ? xcd * (q + 1) : r * (q + 1) + (xcd - r) * q) + off; }
        const int nig = WGM * nN, gid = wgid / nig, fm = gid * WGM, gsz = (nM - fm) < WGM ? (nM - fm) : WGM;
        u.pm = fm + ((wgid % nig) % gsz); u.pn = (wgid % nig) / gsz; return true;
    }
    __device__ __forceinline__ void a_ready(const Unit&) const {}
    __device__ __forceinline__ void done(const Unit&) const {}
};

__device__ __forceinline__ unsigned cvt_pk_bf16(float lo, float hi) { unsigned r; asm volatile("v_cvt_pk_bf16_f32 %0, %1, %2" : "=v"(r) : "v"(lo), "v"(hi)); return r; }
typedef float f32x2 __attribute__((ext_vector_type(2)));
__device__ __forceinline__ f32x2 gelu_pk(f32x2 v) {
    const f32x2 av = __builtin_elementwise_abs(v), d = av * 0.2316418882f + 1.0f;
    f32x2 t; t.x = __builtin_amdgcn_rcpf(d.x); t.y = __builtin_amdgcn_rcpf(d.y);
    f32x2 q = t * 0.5307027145f + (-0.7265760135f); q = q * t + 0.7107068705f; q = q * t + (-0.142248368f); q = q * t + 0.127414796f; q = q * t;
    const f32x2 s = (v * v) * (-0.72134752044f);
    f32x2 e; e.x = __builtin_amdgcn_exp2f(s.x); e.y = __builtin_amdgcn_exp2f(s.y);
    const f32x2 m = v * (q * e), r = v - m;
    f32x2 o; o.x = v.x < 0.f ? m.x : r.x; o.y = v.y < 0.f ? m.y : r.y; return o;
}

template <int ACT  > struct EpiBf16 {
    static constexpr bool PERM = true, AFTER_DRAIN = false; static_assert(ACT == 0 || ACT == 1, "EpiBf16: ACT is 0 (none) or 1 (gelu_pk)");
    bf16_t* O; int ldc; const float* bias; int split_cols; size_t split_stride; float scale0;
    __device__ __forceinline__ void operator()(const f32x4 (&acc)[2][2][4][2], const Unit& u, int wr, int wc, int fr, int fq) const {
        const int row0 = u.pm * BM + wr * 64 + fr; int colt = u.pn * BM; bf16_t* base = O;
        float sc = 1.f; if (split_cols) { const int t = colt / split_cols; base += (size_t)t * split_stride; colt -= t * split_cols; if (t == 0) sc = scale0; }
        const int col0 = colt + wc * 32 + 8 * fq, bcol0 = u.pn * BM + wc * 32 + 8 * fq;
        f32x4 bv[2][2];
#pragma unroll
        for (int bj = 0; bj < 2; ++bj)
#pragma unroll
            for (int n = 0; n < 2; ++n) bv[bj][n] = bias ? *(const f32x4*)(bias + bcol0 + bj * HALF + 4 * n) : (f32x4){0.f, 0.f, 0.f, 0.f};
#pragma unroll
        for (int ai = 0; ai < 2; ++ai)
#pragma unroll
            for (int m = 0; m < 4; ++m) { bf16_t* rowp = base + (size_t)(row0 + ai * HALF + m * 16) * ldc + col0;
#pragma unroll
                for (int bj = 0; bj < 2; ++bj) { f32x4 v0 = acc[ai][bj][m][0] + bv[bj][0], v1 = acc[ai][bj][m][1] + bv[bj][1];
                    if (ACT == 1) { f32x2 a = gelu_pk((f32x2){v0[0], v0[1]}), b = gelu_pk((f32x2){v0[2], v0[3]}), c = gelu_pk((f32x2){v1[0], v1[1]}), d = gelu_pk((f32x2){v1[2], v1[3]});
                        v0 = (f32x4){a.x, a.y, b.x, b.y}; v1 = (f32x4){c.x, c.y, d.x, d.y}; }
                    v0 = v0 * sc; v1 = v1 * sc; u32x4 w; w.x = cvt_pk_bf16(v0[0], v0[1]); w.y = cvt_pk_bf16(v0[2], v0[3]); w.z = cvt_pk_bf16(v1[0], v1[1]); w.w = cvt_pk_bf16(v1[2], v1[3]);
                    *(u32x4*)(rowp + bj * HALF) = w; } }
    }
};


__device__ __forceinline__ float bf_lo(unsigned w) { return __uint_as_float(w << 16); }
__device__ __forceinline__ float bf_hi(unsigned w) { return __uint_as_float(w & 0xffff0000u); }
__device__ __forceinline__ float sigm(float x) { return __builtin_amdgcn_rcpf(1.f + __expf(-x)); }
typedef unsigned u32x2 __attribute__((ext_vector_type(2)));
template <int MODE> struct EpiBranch {
    static constexpr bool PERM = true, AFTER_DRAIN = false;
    bf16_t* T; bf16_t* Mo; const bf16_t* Z; int zld; int zoff; int ldc;
    __device__ __forceinline__ void operator()(const f32x4 (&acc)[2][2][4][2], const Unit& u, int wr, int wc, int fr, int fq) const {
        const int row0 = u.pm * BM + wr * 64 + fr, col0 = u.pn * BM + wc * 32 + 8 * fq;
#pragma unroll
        for (int am = 0; am < 4; ++am) { const int ai = am >> 1, mb = (am & 1) * 2;
            u32x2 zz[4][2][2], tw[4][2][2];
#pragma unroll
            for (int m = mb; m < mb + 2; ++m) { const size_t row = (size_t)(row0 + ai * HALF + m * 16);
#pragma unroll
                for (int bj = 0; bj < 2; ++bj)
#pragma unroll
                    for (int n = 0; n < 2; ++n) { const int col = col0 + bj * HALF + n * 4; zz[m][bj][n] = *(const u32x2*)(Z + row * zld + zoff + col); if (MODE == 1) tw[m][bj][n] = *(const u32x2*)(T + row * ldc + col); } }
#pragma unroll
            for (int m = mb; m < mb + 2; ++m) { const size_t row = (size_t)(row0 + ai * HALF + m * 16);
#pragma unroll
                for (int bj = 0; bj < 2; ++bj)
#pragma unroll
                    for (int n = 0; n < 2; ++n) { const int col = col0 + bj * HALF + n * 4; const u32x2 z2 = zz[m][bj][n];
                        f32x4 gt; gt[0] = sigm(bf_lo(z2.x)); gt[1] = sigm(bf_hi(z2.x)); gt[2] = sigm(bf_lo(z2.y)); gt[3] = sigm(bf_hi(z2.y));
                        f32x4 v = acc[ai][bj][m][n] * gt;
                        if (MODE == 1) { const u32x2 t2 = tw[m][bj][n]; f32x4 t; t[0] = bf_lo(t2.x); t[1] = bf_hi(t2.x); t[2] = bf_lo(t2.y); t[3] = bf_hi(t2.y); v = v + t; }
                        u32x2 w; w.x = cvt_pk_bf16(v[0], v[1]); w.y = cvt_pk_bf16(v[2], v[3]); *(u32x2*)((MODE == 0 ? T : Mo) + row * ldc + col) = w; } } }
    }
};
struct EpiRes {
    static constexpr bool PERM = false, AFTER_DRAIN = false;
    const float* baseP; const float* baseS; float* out; int ldc; int split;
    __device__ __forceinline__ void operator()(const f32x4 (&acc)[2][2][4][2], const Unit& u, int wr, int wc, int fr, int fq) const {
        const int row0 = u.pm * BM + wr * 64 + fr, col0 = u.pn * BM + wc * 32 + 4 * fq;
#pragma unroll
        for (int am = 0; am < 4; ++am) { const int ai = am >> 1, mb = (am & 1) * 2; f32x4 bv[4][2][2];
#pragma unroll
            for (int m = mb; m < mb + 2; ++m) { const int row = row0 + ai * HALF + m * 16;
                const float* bp = (row < split ? baseP + (size_t)row * ldc : baseS + (size_t)(row - split) * ldc) + col0;
#pragma unroll
                for (int bj = 0; bj < 2; ++bj)
#pragma unroll
                    for (int n = 0; n < 2; ++n) bv[m][bj][n] = *(const f32x4*)(bp + bj * HALF + n * 16); }
#pragma unroll
            for (int m = mb; m < mb + 2; ++m) { const int row = row0 + ai * HALF + m * 16; float* op = out + (size_t)row * ldc + col0;
#pragma unroll
                for (int bj = 0; bj < 2; ++bj)
#pragma unroll
                    for (int n = 0; n < 2; ++n) *(f32x4*)(op + bj * HALF + n * 16) = acc[ai][bj][m][n] + bv[m][bj][n]; } }
    }
};

__device__ __forceinline__ float dpp_shr1(float x) { return __int_as_float(__builtin_amdgcn_update_dpp(0, __float_as_int(x), 0x111, 0xf, 0xf, false)); }
__device__ __forceinline__ float dpp_shr2(float x) { return __int_as_float(__builtin_amdgcn_update_dpp(0, __float_as_int(x), 0x112, 0xf, 0xf, false)); }
__device__ __forceinline__ float dpp_ror1(float x) { return __int_as_float(__builtin_amdgcn_update_dpp(0, __float_as_int(x), 0x121, 0xf, 0xf, false)); }
__device__ __forceinline__ float dpp_ror2(float x) { return __int_as_float(__builtin_amdgcn_update_dpp(0, __float_as_int(x), 0x122, 0xf, 0xf, false)); }
__device__ __forceinline__ float dpp_shr1_or(float old, float x) { return __int_as_float(__builtin_amdgcn_update_dpp(__float_as_int(old), __float_as_int(x), 0x111, 0xf, 0xf, false)); }
__device__ __forceinline__ float dpp_shr2_or(float old, float x) { return __int_as_float(__builtin_amdgcn_update_dpp(__float_as_int(old), __float_as_int(x), 0x112, 0xf, 0xf, false)); }
struct EpiResNorm {
    static constexpr bool PERM = true, AFTER_DRAIN = false;
    const float* base; float* out; bf16_t* Hn; const float* gain; float* SSP; int ldc;
    __device__ __forceinline__ void operator()(const f32x4 (&acc)[2][2][4][2], const Unit& u, int wr, int wc, int fr, int fq) const {
        const int row0 = u.pm * BM + wr * 64 + fr, col0 = u.pn * BM + wc * 32 + 8 * fq;
        f32x4 gv[2][2];
#pragma unroll
        for (int bj = 0; bj < 2; ++bj)
#pragma unroll
            for (int n = 0; n < 2; ++n) gv[bj][n] = *(const f32x4*)(gain + col0 + bj * HALF + n * 4);
#pragma unroll
        for (int am = 0; am < 4; ++am) { const int ai = am >> 1, mb = (am & 1) * 2; f32x4 bv[4][2][2];
#pragma unroll
            for (int m = mb; m < mb + 2; ++m) { const size_t o = (size_t)(row0 + ai * HALF + m * 16) * ldc + col0;
#pragma unroll
                for (int bj = 0; bj < 2; ++bj)
#pragma unroll
                    for (int n = 0; n < 2; ++n) bv[m][bj][n] = *(const f32x4*)(base + o + bj * HALF + n * 4); }
#pragma unroll
            for (int m = mb; m < mb + 2; ++m) { const size_t row = (size_t)(row0 + ai * HALF + m * 16); const size_t o = row * ldc + col0; float ss = 0.f;
#pragma unroll
                for (int bj = 0; bj < 2; ++bj)
#pragma unroll
                    for (int n = 0; n < 2; ++n) { const f32x4 x = bv[m][bj][n] + acc[ai][bj][m][n]; *(f32x4*)(out + o + bj * HALF + n * 4) = x;
                        ss += (x[0] * x[0] + x[1] * x[1]) + (x[2] * x[2] + x[3] * x[3]); const f32x4 h = x * gv[bj][n];
                        u32x2 w; w.x = cvt_pk_bf16(h[0], h[1]); w.y = cvt_pk_bf16(h[2], h[3]); *(u32x2*)(Hn + o + bj * HALF + n * 4) = w; }
                ss += __shfl_xor(ss, 16); ss += __shfl_xor(ss, 32);
                if (fq == 0) SSP[row * 16 + u.pn * 4 + wc] = ss; } }
    }
};
struct EpiFfn {
    static constexpr bool PERM = true, AFTER_DRAIN = false;
    bf16_t* G; const PG8_LAS float* rsl; const PG8_LAS int* slots; const PG8_LAS float* cwl; float* RAW; float* HALO; int mp, dff;
    __device__ __forceinline__ void operator()(const f32x4 (&acc)[2][2][4][2], const Unit& u, int wr, int wc, int fr, int fq) const {
        const int ca = u.pn * 128 + wc * 32 + 8 * fq;
        f32x4 cb[2], w0[2], w1[2], w2[2];
        const bool smp = u.pm * BM >= mp;
        const int slot = slots[u.pm], ct = slots[128 + u.pn] * 512 + wc * 32 + 8 * fq;
#pragma unroll
        for (int n = 0; n < 2; ++n) { cb[n] = *(const PG8_LAS f32x4*)(cwl + ct + 4 * n); w0[n] = *(const PG8_LAS f32x4*)(cwl + ct + 128 + 4 * n); w1[n] = *(const PG8_LAS f32x4*)(cwl + ct + 256 + 4 * n); w2[n] = *(const PG8_LAS f32x4*)(cwl + ct + 384 + 4 * n); }
#pragma unroll
        for (int ai = 0; ai < 2; ++ai) { f32x4 ap[2] = {(f32x4){0.f, 0.f, 0.f, 0.f}, (f32x4){0.f, 0.f, 0.f, 0.f}};
#pragma unroll
            for (int m = 0; m < 4; ++m) { const int rl = ai * HALF + wr * 64 + m * 16 + fr, row = u.pm * BM + rl;
                const float rs = rsl[slot * 256 + rl];
                const bool rawrow = smp ? ((fr & 7) < 2) : (m == 0 && fr < 2), halorow = smp ? ((fr & 7) >= 6) : (m == 3 && fr >= 14);
                int ridx, hidx;
                if (!smp) { const int blk = row >> 6; ridx = blk * 2 + fr; hidx = blk * 2 + (fr - 14); } else { const int rr = row - mp; ridx = 512 + (rr >> 3) * 2 + (fr & 7); hidx = 512 + (rr >> 3) * 2 + (fr & 7) - 6; }
                f32x4 a0s[2], bbs[2]; u32x4 gw;
#pragma unroll
                for (int n = 0; n < 2; ++n) { const f32x4 a0 = acc[ai][0][m][n] * rs, bb = acc[ai][1][m][n] * rs; f32x4 g;
#pragma unroll
                    for (int j = 0; j < 4; ++j) { const float r1 = dpp_ror1(ap[n][j]), r2 = dpp_ror2(ap[n][j]);
                        const float a1 = dpp_shr1_or(r1, a0[j]), a2 = dpp_shr2_or(r2, a0[j]);
                        const float cv = cb[n][j] + w0[n][j] * a2 + w1[n][j] * a1 + w2[n][j] * a0[j]; g[j] = cv * sigm(cv) * bb[j]; }
                    gw[2 * n] = cvt_pk_bf16(g[0], g[1]); gw[2 * n + 1] = cvt_pk_bf16(g[2], g[3]); a0s[n] = a0; bbs[n] = bb;
                    ap[n] = a0; }
                if (rawrow) { float* r0p = RAW + (size_t)ridx * 2 * dff + ca; *(f32x4*)r0p = a0s[0]; *(f32x4*)(r0p + 4) = a0s[1]; *(f32x4*)(r0p + dff) = bbs[0]; *(f32x4*)(r0p + dff + 4) = bbs[1]; }
                else *(u32x4*)(G + (size_t)row * dff + ca) = gw;
                if (halorow) { float* hp = HALO + (size_t)hidx * dff + ca; *(f32x4*)hp = a0s[0]; *(f32x4*)(hp + 4) = a0s[1]; } } }
    }
};

__device__ __forceinline__ bool static_unit(int nM, int nN, int G, int c, int i, int& pm, int& pn) {
    const int nwg = nM * nN; const long L = (long)i * G + c; if (L >= nwg) return false;
    int wgid = (int)L; { const int q = nwg / NXCD, r = nwg % NXCD, xcd = wgid % NXCD, off = wgid / NXCD; wgid = (xcd < r ? xcd * (q + 1) : r * (q + 1) + (xcd - r) * q) + off; }
    const int nig = WGM * nN, gid = wgid / nig, fm = gid * WGM, gsz = (nM - fm) < WGM ? (nM - fm) : WGM;
    pm = fm + ((wgid % nig) % gsz); pn = (wgid % nig) / gsz; return true;
}
template <class Epi, class Sched, bool ALIGN_EPI = false, bool SP2 = false>
__device__ __forceinline__ void gemm_phase(PG8_LAS unsigned char* lds, const Gemm g, const Sched& S, const Epi& E, const int tid_in) {
    const int tid = tid_in, wid = __builtin_amdgcn_readfirstlane(tid >> 6), lane = tid & 63, wr = wid >> 2, wc = wid & 3, fr = lane & 15, fq = lane >> 4;
    const int K = g.K, nt = K / BK;
    unsigned voffA[2], voffB[2];
#pragma unroll
    for (int i = 0; i < 2; ++i) { int R, C; stage_rc(tid * 16 + i * 8192, R, C); const int Rb = Epi::PERM ? ((R & ~31) + perm32(R & 31)) : R;
        voffA[i] = (unsigned)(R * K + C) * 2u; voffB[i] = (unsigned)(Rb * K + C) * 2u; }
    const size_t kstep = (size_t)(BK * 2);
    const size_t hstep = (size_t)HALF * K * 2;
    const size_t tstep = 2 * hstep;
    const unsigned ldsw = (unsigned)wid * 1024u;
    const int aoff = lds_byte(wr * 64 + fr, fq * 8), boff = lds_byte(wc * 32 + fr, fq * 8);
#define PG8_SA(b, h) (((b) * 2 + (h)) * HTB)
#define PG8_SB(b, h) ((4 + (b) * 2 + (h)) * HTB)
#define PG8_STAGE(bufoff, gbase, voff) do { _Pragma("unroll") for (int _i = 0; _i < 2; ++_i) \
        __builtin_amdgcn_global_load_lds((const unsigned*)((const char*)(gbase) + (voff)[_i]), (PG8_LAS unsigned*)(lds + (bufoff) + ldsw + _i * 8192), 16, 0, 0); } while (0)
#define PG8_LDA(dst, b, h) do { _Pragma("unroll") for (int m = 0; m < 4; ++m) _Pragma("unroll") for (int k = 0; k < 2; ++k) dst[m][k] = *(const PG8_LAS bf16x8*)(lds + PG8_SA(b, h) + aoff + m * 2048 + k * 1024); } while (0)
#define PG8_LDB(dst, b, h) do { _Pragma("unroll") for (int n = 0; n < 2; ++n) _Pragma("unroll") for (int k = 0; k < 2; ++k) dst[n][k] = *(const PG8_LAS bf16x8*)(lds + PG8_SB(b, h) + boff + n * 2048 + k * 1024); } while (0)
#define PG8_MMA(ai, bj, At, Bt) do { __builtin_amdgcn_s_setprio(1); _Pragma("unroll") for (int m = 0; m < 4; ++m) _Pragma("unroll") for (int n = 0; n < 2; ++n) _Pragma("unroll") for (int k = 0; k < 2; ++k) \
        acc[ai][bj][m][n] = __builtin_amdgcn_mfma_f32_16x16x32_bf16(Bt[n][k], At[m][k], acc[ai][bj][m][n], 0, 0, 0); __builtin_amdgcn_s_setprio(0); } while (0)
#define PG8_WAIT_V(n) asm volatile("s_waitcnt vmcnt(" #n ")" ::: "memory")
#define PG8_WAIT_L(n) asm volatile("s_waitcnt lgkmcnt(" #n ")" ::: "memory")
#define PG8_BAR __builtin_amdgcn_s_barrier()
#define PG8_SCHED __builtin_amdgcn_sched_barrier(0)
    Unit cur, nxt; int ui = 0;
    if (!S.next(0, cur)) return;
    f32x4 acc[2][2][4][2];
#pragma unroll
    for (int a = 0; a < 2; ++a)
#pragma unroll
        for (int b = 0; b < 2; ++b)
#pragma unroll
            for (int m = 0; m < 4; ++m)
#pragma unroll
                for (int n = 0; n < 2; ++n) acc[a][b][m][n] = (f32x4){0.f, 0.f, 0.f, 0.f};
    bf16x8 At[4][2], B0[2][2], B1[2][2];
    const char* cA = (const char*)g.A + (size_t)cur.pm * tstep; const char* cB = (const char*)g.Bt + (size_t)cur.pn * tstep;
    S.a_ready(cur);
    if constexpr (SP2) {
        PG8_STAGE(PG8_SB(0, 0), cB, voffB); PG8_STAGE(PG8_SB(0, 1), cB + hstep, voffB); PG8_STAGE(PG8_SA(0, 0), cA, voffA); PG8_STAGE(PG8_SA(0, 1), cA + hstep, voffA);
        if (wr == 1) PG8_BAR;
        PG8_WAIT_V(2); PG8_BAR;
        PG8_STAGE(PG8_SB(1, 0), cB + kstep, voffB); PG8_STAGE(PG8_SA(1, 0), cA + kstep, voffA); PG8_STAGE(PG8_SB(1, 1), cB + hstep + kstep, voffB);
        PG8_WAIT_V(6); PG8_BAR;
    } else {
        PG8_STAGE(PG8_SB(0, 0), cB, voffB); PG8_STAGE(PG8_SA(0, 0), cA, voffA); PG8_STAGE(PG8_SB(0, 1), cB + hstep, voffB); PG8_STAGE(PG8_SA(0, 1), cA + hstep, voffA);
        if (wr == 1) PG8_BAR;
        PG8_WAIT_V(4); PG8_BAR;
        PG8_STAGE(PG8_SB(1, 0), cB + kstep, voffB); PG8_STAGE(PG8_SA(1, 0), cA + kstep, voffA); PG8_STAGE(PG8_SB(1, 1), cB + hstep + kstep, voffB);
        PG8_WAIT_V(6); PG8_BAR;
    }
    for (;;) {
        const bool has_next = S.next(ui + 1, nxt);
        const char* nA = has_next ? (const char*)g.A + (size_t)nxt.pm * tstep : cA; const char* nB = has_next ? (const char*)g.Bt + (size_t)nxt.pn * tstep : cB;
        for (int t = 0; t < nt; t += 2) {
            const bool last = (t == nt - 2);
            const char* a1 = cA + (size_t)(t + 1) * kstep;
            const char* a2 = last ? nA : cA + (size_t)(t + 2) * kstep; const char* b2 = last ? nB : cB + (size_t)(t + 2) * kstep;
            const char* a3 = a2 + kstep; const char* b3 = b2 + kstep;
            if (last && has_next) S.a_ready(nxt);
            if constexpr (SP2) {
            PG8_LDB(B0, 0, 0); PG8_LDB(B1, 0, 1); PG8_SCHED; PG8_LDA(At, 0, 0); PG8_STAGE(PG8_SA(1, 1), a1 + hstep, voffA);
            PG8_WAIT_V(8); PG8_WAIT_L(0); PG8_BAR; PG8_MMA(0, 0, At, B0); PG8_MMA(0, 1, At, B1); PG8_BAR; PG8_SCHED;
            PG8_LDA(At, 0, 1); PG8_STAGE(PG8_SB(0, 0), b2, voffB); PG8_STAGE(PG8_SB(0, 1), b2 + hstep, voffB); PG8_STAGE(PG8_SA(0, 0), a2, voffA);
            PG8_WAIT_V(8); PG8_WAIT_L(0); PG8_BAR; PG8_MMA(1, 0, At, B0); PG8_MMA(1, 1, At, B1); PG8_BAR; PG8_SCHED;
            PG8_LDB(B0, 1, 0); PG8_LDB(B1, 1, 1); PG8_SCHED; PG8_LDA(At, 1, 0); PG8_STAGE(PG8_SA(0, 1), a2 + hstep, voffA);
            PG8_WAIT_V(8); PG8_WAIT_L(0); PG8_BAR; PG8_MMA(0, 0, At, B0); PG8_MMA(0, 1, At, B1); PG8_BAR; PG8_SCHED;
            PG8_LDA(At, 1, 1); PG8_STAGE(PG8_SB(1, 0), b3, voffB); PG8_STAGE(PG8_SB(1, 1), b3 + hstep, voffB); PG8_STAGE(PG8_SA(1, 0), a3, voffA);
            PG8_WAIT_V(8); PG8_WAIT_L(0); PG8_BAR; PG8_MMA(1, 0, At, B0); PG8_MMA(1, 1, At, B1); PG8_BAR; PG8_SCHED;
            } else {
            PG8_LDB(B0, 0, 0); PG8_SCHED; PG8_LDA(At, 0, 0); PG8_STAGE(PG8_SA(1, 1), a1 + hstep, voffA);
            PG8_WAIT_L(8); PG8_BAR; PG8_WAIT_L(0); PG8_MMA(0, 0, At, B0); PG8_BAR; PG8_SCHED;
            PG8_LDB(B1, 0, 1); PG8_STAGE(PG8_SB(0, 0), b2, voffB);
            PG8_BAR; PG8_WAIT_L(0); PG8_MMA(0, 1, At, B1); PG8_BAR;
            PG8_LDA(At, 0, 1); PG8_STAGE(PG8_SA(0, 0), a2, voffA);
            PG8_BAR; PG8_WAIT_L(0); PG8_MMA(1, 0, At, B0); PG8_BAR; PG8_SCHED;
            PG8_STAGE(PG8_SB(0, 1), b2 + hstep, voffB);
            PG8_WAIT_V(6); PG8_BAR; PG8_MMA(1, 1, At, B1); PG8_BAR;
            PG8_LDB(B0, 1, 0); PG8_SCHED; PG8_LDA(At, 1, 0); PG8_STAGE(PG8_SA(0, 1), a2 + hstep, voffA);
            PG8_WAIT_L(8); PG8_BAR; PG8_WAIT_L(0); PG8_MMA(0, 0, At, B0); PG8_BAR; PG8_SCHED;
            PG8_LDB(B1, 1, 1); PG8_STAGE(PG8_SB(1, 0), b3, voffB);
            PG8_BAR; PG8_WAIT_L(0); PG8_MMA(0, 1, At, B1); PG8_BAR;
            PG8_LDA(At, 1, 1); PG8_STAGE(PG8_SA(1, 0), a3, voffA);
            PG8_BAR; PG8_WAIT_L(0); PG8_MMA(1, 0, At, B0); PG8_BAR; PG8_SCHED;
            PG8_STAGE(PG8_SB(1, 1), b3 + hstep, voffB);
            PG8_WAIT_V(6); PG8_BAR; PG8_MMA(1, 1, At, B1); PG8_BAR;
            }
        }
        if constexpr (ALIGN_EPI) { if (wr == 0) PG8_BAR; }
        if constexpr (!Epi::AFTER_DRAIN) { E(acc, cur, wr, wc, fr, fq); S.done(cur); }
        if (!has_next) break;
#pragma unroll
        for (int a = 0; a < 2; ++a)
#pragma unroll
            for (int b = 0; b < 2; ++b)
#pragma unroll
                for (int m = 0; m < 4; ++m)
#pragma unroll
                    for (int n = 0; n < 2; ++n) acc[a][b][m][n] = (f32x4){0.f, 0.f, 0.f, 0.f};
        cur = nxt; cA = nA; cB = nB; ++ui;
        if constexpr (ALIGN_EPI) { if (wr == 1) PG8_BAR; }
    }
    PG8_WAIT_V(0);
    if constexpr (!ALIGN_EPI) { if (wr == 0) PG8_BAR; }
    PG8_BAR;
    if constexpr (Epi::AFTER_DRAIN) { E.fused(acc, cur, wr, wc, fr, fq, lds, wid, lane); S.done(cur); }
#undef PG8_SA
#undef PG8_SB
#undef PG8_STAGE
#undef PG8_LDA
#undef PG8_LDB
#undef PG8_MMA
#undef PG8_WAIT_V
#undef PG8_WAIT_L
#undef PG8_BAR
#undef PG8_SCHED
}
}

constexpr int DM = 1024, NBAT = 4, SEQ = 4096, MP = NBAT * SEQ, DECB = 32, TS = 8, MS = DECB * TS, MT = MP + MS;
constexpr int PAST = 16384, PAGE = 128, NPG = PAST / PAGE;
constexpr int DIN = 5400, DINP = 5632, DFF = 2816, DFF2 = 5632;
constexpr int ZQ = 0, ZKC = 512, ZGA = 1280, ZQB = 1304, ZFB = 1816, ZIB = 2328, ZGB = 2840, ZMG = 3352;
constexpr int NCH_P = 256, NCH_S = 1024;
constexpr int CROWS = NBAT * NCH_P + DECB * NCH_S;
constexpr float EPS = 1e-6f;
constexpr size_t O_YP = 0, O_YS = 16777216, O_CKP = 17039360, O_CKS = 21233664, O_SKP = 21299200, O_SKS = 25493504, O_WKP = 25559040, O_WKS = 26083328,
                 O_HP = 30277632, O_HS = 30539776, O_FCP = 32636928, O_FCS = 32659456, O_END = 32839680;
constexpr size_t MiB = 1u << 20;
constexpr size_t WS_CTL = 0, CTL_ZERO_BYTES = 1 * MiB;
constexpr size_t WS_WIN = 2 * MiB, WS_WBA = 14 * MiB, WS_WBB = 15 * MiB, WS_WOUT = 16 * MiB, WS_WFIN = 18 * MiB, WS_WFOUT = 29 * MiB, WS_W1T = 35 * MiB, WS_ROPE = 36 * MiB, WS_LB = 38 * MiB, WS_CBIAS = 38 * MiB + 4096, WS_M0 = 38 * MiB + 8192;
constexpr size_t WS_H = 40 * MiB, WS_Z = 80 * MiB, WS_QR = 260 * MiB, WS_KVC = 280 * MiB, WS_KVS = 290 * MiB, WS_KVW = 300 * MiB, WS_GATES = 310 * MiB, WS_PBUF = 312 * MiB, WS_KC = 380 * MiB, WS_VC = 390 * MiB;
constexpr size_t WS_U = 400 * MiB, WS_SP = 464 * MiB, WS_OI = 496 * MiB, WS_DEC = 528 * MiB, WS_QI = 530 * MiB, WS_OCS = 546 * MiB, WS_IMPS = 547 * MiB, WS_OWS = 548 * MiB, WS_OA = 550 * MiB, WS_OB = 570 * MiB, WS_RAW = 587 * MiB, WS_VTS = 600 * MiB, WS_VTW = 606 * MiB, WS_VCT = 612 * MiB, WS_HALO = 621 * MiB, WS_T1 = 630 * MiB, WS_SSP = 696 * MiB, WS_MB = 700 * MiB, WS_X1 = 740 * MiB, WS_G = 810 * MiB, WS_END = 900 * MiB;
constexpr int CW_TMO = 0, CW_BAR = 4096, CW_XDONE = 16384;
constexpr int RING_OFF = 0, RING_BYTES = 131072;
constexpr int LDSCTL_OFF = RING_BYTES, MISC_OFF = LDSCTL_OFF + 320;
constexpr int LDS_BYTES = 163840;
constexpr int NWAVES = 8;

#define LAS __attribute__((address_space(3)))
typedef unsigned short bf16;
typedef unsigned v4u __attribute__((ext_vector_type(4)));
typedef unsigned v2u __attribute__((ext_vector_type(2)));
typedef float f32x4 __attribute__((ext_vector_type(4)));
typedef float f32x2 __attribute__((ext_vector_type(2)));
typedef short bf16x8 __attribute__((ext_vector_type(8)));
#define LDS_WAIT() asm volatile("s_waitcnt lgkmcnt(0)" ::: "memory")
typedef float f32x2_t_ __attribute__((ext_vector_type(2))); typedef __bf16 bf16x2_t_ __attribute__((ext_vector_type(2)));
__device__ __forceinline__ unsigned pkbf(float lo, float hi) { const f32x2_t_ v = {lo, hi}; const bf16x2_t_ b = __builtin_convertvector(v, bf16x2_t_); return __builtin_bit_cast(unsigned, b); }
__device__ __forceinline__ unsigned f2bf(float f) { return pkbf(f, 0.f) & 0xffffu; }
__device__ __forceinline__ unsigned pk2(float lo, float hi) { return pkbf(lo, hi); }
__device__ __forceinline__ float ex2(float x) { return __builtin_amdgcn_exp2f(x); }
constexpr float QSCALE = 0.125f * 1.4426950408889634f;
__device__ __forceinline__ float bf2f(unsigned short b) { return __uint_as_float(((unsigned)b) << 16); }
__device__ __forceinline__ float bflo(unsigned w) { return __uint_as_float(w << 16); }
__device__ __forceinline__ float bfhi(unsigned w) { return __uint_as_float(w & 0xffff0000u); }
__device__ __forceinline__ float sigm(float x) { return __builtin_amdgcn_rcpf(1.f + __expf(-x)); }
__device__ __forceinline__ float silu(float x) { return x * __builtin_amdgcn_rcpf(1.f + __expf(-x)); }
#define DPPF(old, x, ctrl, rm) __int_as_float(__builtin_amdgcn_update_dpp(__float_as_int(old), __float_as_int(x), ctrl, rm, 0xf, false))
__device__ __forceinline__ float wave_sum(float v) {
    v += DPPF(0.f, v, 0xB1, 0xf); v += DPPF(0.f, v, 0x4E, 0xf); v += DPPF(0.f, v, 0x141, 0xf); v += DPPF(0.f, v, 0x140, 0xf);
    v += DPPF(0.f, v, 0x142, 0xa); v += DPPF(0.f, v, 0x143, 0xc);
    return __int_as_float(__builtin_amdgcn_readlane(__float_as_int(v), 63));
}
__device__ __forceinline__ float wave_max(float v) {
    v = fmaxf(v, DPPF(v, v, 0xB1, 0xf)); v = fmaxf(v, DPPF(v, v, 0x4E, 0xf)); v = fmaxf(v, DPPF(v, v, 0x141, 0xf)); v = fmaxf(v, DPPF(v, v, 0x140, 0xf));
    v = fmaxf(v, DPPF(v, v, 0x142, 0xa)); v = fmaxf(v, DPPF(v, v, 0x143, 0xc));
    return __int_as_float(__builtin_amdgcn_readlane(__float_as_int(v), 63));
}
__device__ __forceinline__ int crow_base(int seq) { return seq < NBAT ? seq * NCH_P : NBAT * NCH_P + (seq - NBAT) * NCH_S; }
#define XB_TMO      128
#define XB_XCNT(j)  (256  + 64 * (j))
#define XB_XSUB(j)  (1280 + 64 * (j))
#define XB_XGEN(j)  (2304 + 64 * (j))
#define XB_TOP      3328
#define XB_TOPGEN   3392
#define XCD_BAR_WORDS 3456
#define XB_SPIN_CAP (1u << 18)

__device__ __forceinline__ unsigned xb_ld(unsigned* p)              { return __hip_atomic_load(p, __ATOMIC_RELAXED, __HIP_MEMORY_SCOPE_AGENT); }
__device__ __forceinline__ unsigned xb_add(unsigned* p, unsigned v) { return __hip_atomic_fetch_add(p, v, __ATOMIC_RELAXED, __HIP_MEMORY_SCOPE_AGENT); }
__device__ __forceinline__ unsigned xb_xcc_id() { return (unsigned)__builtin_amdgcn_s_getreg((3 << 11) | 20) & 0xFu; }
#define XB_SPIN(cond, bar) do { unsigned _sp = 0; while (cond) { __builtin_amdgcn_s_sleep(1); \
    if ((++_sp & 255u) == 0u) { if (xb_ld(&(bar)[XB_TMO])) break; if (_sp > XB_SPIN_CAP) { atomicAdd(&(bar)[XB_TMO], 1u); break; } } } } while (0)

struct XcdBarrier {
    unsigned* bar; unsigned x;
    volatile LAS unsigned* st;
};

__device__ __forceinline__ XcdBarrier xcd_barrier_post(unsigned* bar, volatile LAS unsigned* st) {
    XcdBarrier b; b.bar = bar; b.x = xb_xcc_id(); b.st = st;
    if (threadIdx.x == 0) (void)xb_add(&bar[XB_XCNT(b.x)], 1u);
    return b;
}
__device__ __forceinline__ void xcd_barrier_complete(unsigned* bar, unsigned x, unsigned& nloc, unsigned& nx) {
    const unsigned G = gridDim.x * gridDim.y * gridDim.z;
    unsigned sum, cnt, mine, sp = 0u;
    for (;;) {
        sum = 0u; cnt = 0u; mine = 0u;
#pragma unroll
        for (unsigned j = 0; j < 16; ++j) { const unsigned c = xb_ld(&bar[XB_XCNT(j)]); sum += c; cnt += (c > 0u) ? 1u : 0u; mine = (j == x) ? c : mine; }
        if (sum == G) break;
        __builtin_amdgcn_s_sleep(1);
        if ((++sp & 255u) == 0u) { if (xb_ld(&bar[XB_TMO])) break; if (sp > XB_SPIN_CAP) { atomicAdd(&bar[XB_TMO], 1u); break; } }
    }
    nloc = mine > 0u ? mine : 1u; nx = cnt > 0u ? cnt : 1u;
}

__device__ __forceinline__ void xcd_barrier(const XcdBarrier& b, const int tid_now) {
    asm volatile("s_waitcnt vmcnt(0)" ::: "memory");
    __syncthreads();
    if (tid_now == 0) {
        unsigned* bar = b.bar;
        __builtin_amdgcn_s_waitcnt(0);
        unsigned nloc = b.st[0], nx = b.st[1];
        if (nloc == 0u) { xcd_barrier_complete(bar, b.x, nloc, nx); b.st[0] = nloc; b.st[1] = nx; }
        const unsigned old = xb_add(&bar[XB_XSUB(b.x)], 1u);
        const unsigned gen = old / nloc;
        if (old + 1u == (gen + 1u) * nloc) {
            __builtin_amdgcn_fence(__ATOMIC_RELEASE, "agent");
            asm volatile("s_waitcnt vmcnt(0)" ::: "memory");
            const unsigned og = xb_add(&bar[XB_TOP], 1u);
            const unsigned tg = og / nx;
            if (og + 1u == (tg + 1u) * nx) xb_add(&bar[XB_TOPGEN], 1u);
            else XB_SPIN(xb_ld(&bar[XB_TOPGEN]) == tg, bar);
            __builtin_amdgcn_fence(__ATOMIC_ACQUIRE, "agent");
            xb_add(&bar[XB_XGEN(b.x)], 1u);
            asm volatile("s_waitcnt vmcnt(0)" ::: "memory");
        } else {
            XB_SPIN(xb_ld(&bar[XB_XGEN(b.x)]) == gen, bar);
            __builtin_amdgcn_fence(__ATOMIC_ACQUIRE, "agent");
            asm volatile("s_waitcnt vmcnt(0)" ::: "memory");
        }
    }
    __syncthreads();
}

struct Frame {
    LAS unsigned char* lds;
    int tid, lane, wave, vcu, G;
    const float *xp, *xs, *cache_cmp, *cache_slc, *st_win, *st_hgrn, *st_conv, *attn_g, *w_in, *q_g, *k_g, *pos_emb, *cmp_w1, *cmp_w2, *lb_logits, *hgrn_g, *w_branch, *w_out, *ffn_g, *ffn_w_in, *conv_w, *conv_b, *ffn_w_out;
    const int* ptab;
    float* out;
    bf16 *WIN, *WBA, *WBB, *WOUT, *WFIN, *WFOUT, *W1T, *H, *Z, *QR, *KVC, *KVS, *KVW, *KC, *VC, *VCT, *VTS, *VTW, *SP, *QI, *OA, *OB, *MB, *GB;
    float *ROPE, *LB, *CBIAS, *M0, *RAW, *HALO, *SSP, *OCS, *IMPS, *OWS, *GATES, *PBUF, *U, *OI, *DEC, *T1, *X1;
};

__device__ __forceinline__ int ffn_perm(int n) { return n < DFF ? (n >> 7) * 256 + (n & 127) : ((n - DFF) >> 7) * 256 + 128 + ((n - DFF) & 127); }
__device__ __forceinline__ void transpose_load(float (&tv)[32], const float* W, int ld, int N, int Nvalid, int item, int lane) {
    const int nblk = N / 32, kb = item / nblk, nb = item % nblk, k0 = 64 * kb, nn = 32 * nb + (lane & 31);
#pragma unroll
    for (int i = 0; i < 32; ++i) { const int kk = 2 * i + (lane >> 5); tv[i] = nn < Nvalid ? W[(size_t)(k0 + kk) * ld + nn] : 0.f; }
}
__device__ __forceinline__ void transpose_item(const float* W, int ld, int K, int N, int Nvalid, bf16* WT, int row_off, LAS float* scr, int item, int lane, bool perm = false) {
    const int nblk = N / 32, kb = item / nblk, nb = item % nblk, k0 = 64 * kb, n0 = 32 * nb;
    const int nn = n0 + (lane & 31);
    float tv[32];
#pragma unroll
    for (int i = 0; i < 32; ++i) { const int kk = 2 * i + (lane >> 5); tv[i] = nn < Nvalid ? W[(size_t)(k0 + kk) * ld + nn] : 0.f; }
#pragma unroll
    for (int i = 0; i < 32; ++i) { const int kk = 2 * i + (lane >> 5); scr[kk * 33 + (lane & 31)] = tv[i]; }
    LDS_WAIT();
    const int c = lane & 7;
#pragma unroll
    for (int j = 0; j < 4; ++j) { const int n = (lane >> 3) + 8 * j; const LAS float* s = scr + (8 * c) * 33 + n;
        v4u o; o.x = pk2(s[0 * 33], s[1 * 33]); o.y = pk2(s[2 * 33], s[3 * 33]); o.z = pk2(s[4 * 33], s[5 * 33]); o.w = pk2(s[6 * 33], s[7 * 33]);
        *(v4u*)(WT + (size_t)(row_off + (perm ? ffn_perm(n0 + n) : n0 + n)) * K + k0 + 8 * c) = o; }
    LDS_WAIT();
}
__device__ __forceinline__ void rms_row_bf16(const float* xrow, const float* g, bf16* orow, int lane) {
    const f32x4* xr = (const f32x4*)xrow + lane; const f32x4* gr = (const f32x4*)g + lane;
    f32x4 v[4]; float s = 0.f;
#pragma unroll
    for (int j = 0; j < 4; ++j) { v[j] = xr[64 * j]; s += (v[j].x * v[j].x + v[j].y * v[j].y) + (v[j].z * v[j].z + v[j].w * v[j].w); }
    const float rs = rsqrtf(wave_sum(s) * (1.f / DM) + EPS);
    unsigned long long* o8 = (unsigned long long*)orow + lane;
#pragma unroll
    for (int j = 0; j < 4; ++j) { const f32x4 gg = gr[64 * j]; o8[64 * j] = (unsigned long long)pk2(v[j].x * rs * gg.x, v[j].y * rs * gg.y) | ((unsigned long long)pk2(v[j].z * rs * gg.z, v[j].w * rs * gg.w) << 32); }
}
__device__ __forceinline__ void p0_prologue(const Frame& F) {
    LAS float* scr = (LAS float*)(F.lds + RING_OFF + F.wave * 16384);
    const int gw = F.vcu * NWAVES + F.wave, NGW = F.G * NWAVES, lane = F.lane;
    constexpr int I_IN = 16 * (DINP / 32), I_BR = 8 * 32, I_OUT = 16 * 32, I_FIN = 16 * (DFF2 / 32), I_FOUT = (DFF / 64) * 32, I_W1 = 16 * 2;
    constexpr int NITEMS = I_IN + 2 * I_BR + I_OUT + I_FIN + I_FOUT + 4 * I_W1;
    for (int it = gw; it < NITEMS; it += NGW) {
        int r = it;
        if (r < I_IN) { transpose_item(F.w_in, DIN, DM, DINP, DIN, F.WIN, 0, scr, r, lane); continue; } r -= I_IN;
        if (r < I_BR) { transpose_item(F.w_branch, DM, 512, DM, DM, F.WBA, 0, scr, r, lane); continue; } r -= I_BR;
        if (r < I_BR) { transpose_item(F.w_branch + (size_t)512 * DM, DM, 512, DM, DM, F.WBB, 0, scr, r, lane); continue; } r -= I_BR;
        if (r < I_OUT) { transpose_item(F.w_out, DM, DM, DM, DM, F.WOUT, 0, scr, r, lane); continue; } r -= I_OUT;
        if (r < I_FIN) { transpose_item(F.ffn_w_in, DFF2, DM, DFF2, DFF2, F.WFIN, 0, scr, r, lane, true); continue; } r -= I_FIN;
        if (r < I_FOUT) { transpose_item(F.ffn_w_out, DM, DFF, DM, DM, F.WFOUT, 0, scr, r, lane); continue; } r -= I_FOUT;
        { const int jr = r / I_W1, rr = r % I_W1;
          transpose_item(F.cmp_w1 + (size_t)jr * 1024 * 64, 64, 1024, 64, 64, F.W1T, jr * 64, scr, rr, lane); }
    }
    for (int m = gw; m < MT; m += 2 * NGW) {
        const int m2 = m + NGW; const bool has2 = m2 < MT;
        const f32x4* x0 = (const f32x4*)(m < MP ? F.xp + (size_t)m * DM : F.xs + (size_t)(m - MP) * DM) + lane;
        const f32x4* x1 = (const f32x4*)(!has2 ? (const float*)x0 - lane * 4 : (m2 < MP ? F.xp + (size_t)m2 * DM : F.xs + (size_t)(m2 - MP) * DM)) + lane;
        const f32x4* gr = (const f32x4*)F.attn_g + lane;
        f32x4 v0[4], v1[4]; float s0 = 0.f, s1 = 0.f;
#pragma unroll
        for (int j = 0; j < 4; ++j) { v0[j] = x0[64 * j]; v1[j] = x1[64 * j]; }
#pragma unroll
        for (int j = 0; j < 4; ++j) { s0 += (v0[j].x * v0[j].x + v0[j].y * v0[j].y) + (v0[j].z * v0[j].z + v0[j].w * v0[j].w); s1 += (v1[j].x * v1[j].x + v1[j].y * v1[j].y) + (v1[j].z * v1[j].z + v1[j].w * v1[j].w); }
        const float r0 = rsqrtf(wave_sum(s0) * (1.f / DM) + EPS), r1 = rsqrtf(wave_sum(s1) * (1.f / DM) + EPS);
        unsigned long long* o0 = (unsigned long long*)(F.H + (size_t)m * DM) + lane; unsigned long long* o1 = (unsigned long long*)(F.H + (size_t)(has2 ? m2 : m) * DM) + lane;
#pragma unroll
        for (int j = 0; j < 4; ++j) { const f32x4 gg = gr[64 * j];
            o0[64 * j] = (unsigned long long)pk2(v0[j].x * r0 * gg.x, v0[j].y * r0 * gg.y) | ((unsigned long long)pk2(v0[j].z * r0 * gg.z, v0[j].w * r0 * gg.w) << 32);
            if (has2) o1[64 * j] = (unsigned long long)pk2(v1[j].x * r1 * gg.x, v1[j].y * r1 * gg.y) | ((unsigned long long)pk2(v1[j].z * r1 * gg.z, v1[j].w * r1 * gg.w) << 32); }
    }
    const int gt = (F.vcu * NWAVES * 64) + F.tid, NGT = F.G * NWAVES * 64;
    for (int e = gt; e < (SEQ + TS) * 32; e += NGT) {
        const int p = e >> 5, i = e & 31; const double pos = (double)(p < SEQ ? p : PAST + (p - SEQ));
        const double inv = exp(-(double)i * (9.210340371976184 / 32.0));
        double a = pos * inv; const double k = rint(a * 0.15915494309189535); a = fma(-k, 6.283185307179586, a); a = fma(-k, 2.4492935982947064e-16, a);
        const float af = (float)a; F.ROPE[2 * e] = cosf(af); F.ROPE[2 * e + 1] = sinf(af);
    }
    for (int e = gt; e < 512; e += NGT) { const float l0 = F.lb_logits[e], l1 = F.lb_logits[512 + e]; F.LB[e] = 1.f / (1.f + expf(l1 - l0)); }
    for (int o = gw; o < 128; o += NGW) { const int j = o >> 6, e = o & 63; float s = 0.f;
        float pe[32], ww[32];
#pragma unroll
        for (int i = 0; i < 32; ++i) { const int f = lane + 64 * i; pe[i] = F.pos_emb[j * 2048 + f]; ww[i] = F.cmp_w1[((size_t)j * 2048 + f) * 64 + e]; }
#pragma unroll
        for (int i = 0; i < 32; ++i) s += pe[i] * ww[i];
        s = wave_sum(s); if (lane == 0) F.CBIAS[o] = s; }
    if (gw == 0) { float mq = fabsf(F.q_g[lane]), mk = fmaxf(fmaxf(fabsf(F.k_g[lane]), fabsf(F.k_g[64 + lane])), fabsf(F.k_g[128 + lane])); mq = wave_max(mq); mk = wave_max(mk);
        if (lane == 0) F.M0[0] = fminf(QSCALE * 64.f * mq * mk, 60.f); }
    for (int e0 = gt; e0 < DECB * 504 * 64; e0 += 8 * NGT) {
        f32x4 cv[8];
#pragma unroll
        for (int i = 0; i < 8; ++i) { const int e = e0 + i * NGT; if (e < DECB * 504 * 64) { const int b = e / (504 * 64), w = e % (504 * 64); cv[i] = ((const f32x4*)F.st_win)[(size_t)b * 512 * 64 + 8 * 64 + w]; } }
#pragma unroll
        for (int i = 0; i < 8; ++i) { const int e = e0 + i * NGT; if (e < DECB * 504 * 64) { const int b = e / (504 * 64), w = e % (504 * 64); ((f32x4*)(F.out + O_WKS))[(size_t)b * 512 * 64 + w] = cv[i]; } }
    }
}

template <int NR> __device__ __forceinline__ void p2_block(const Frame& F, const int rfirst, const int lane, const float qg, const float kg0, const float kg1, const float kg2) {
    {
        const bool smp = rfirst >= MP;
        float vt[4][NR];
        bf16 zv[4][21];
#define P2_LOAD(i_) do { const bf16* z__ = F.Z + (size_t)(rfirst + (i_)) * DINP; _Pragma("unroll") for (int q__ = 0; q__ < 20; ++q__) zv[(i_) & 3][q__] = z__[q__ * 64 + lane]; zv[(i_) & 3][20] = z__[ZGA + (lane < 24 ? lane : 0)]; } while (0)
        P2_LOAD(0); if (NR > 1) P2_LOAD(1 % NR); if (NR > 2) P2_LOAD(2 % NR);
        f32x2 csr[NR];
#pragma unroll
        for (int i = 0; i < NR; ++i) { const int r = rfirst + i; const int p = smp ? SEQ + ((r - MP) % TS) : (r % SEQ); csr[i] = ((const f32x2*)F.ROPE)[p * 32 + (lane & 31)]; }
#pragma unroll
        for (int i = 0; i < NR; ++i) {
            if (i + 3 < NR) P2_LOAD(i + 3);
            const int r = rfirst + i, rr = r - MP;
            const bf16* zrow = zv[i & 3];
            const float c = csr[i].x, s = csr[i].y;
#pragma unroll
            for (int hd = 0; hd < 8; ++hd) {
                const float x = bf2f(zrow[hd]); const float ss = wave_sum(x * x);
                const float y = x * rsqrtf(ss * (1.f / 64.f) + EPS) * qg; const float pr = __shfl_xor(y, 32);
                const float o = lane < 32 ? y * c - pr * s : y * c + pr * s;
                F.QR[(size_t)r * 512 + hd * 64 + lane] = (bf16)f2bf(o * QSCALE);
            }
#pragma unroll
            for (int br = 0; br < 3; ++br) {
                const float kg = br == 0 ? kg0 : (br == 1 ? kg1 : kg2);
                bf16* kvb = (br == 0 ? F.KVC : (br == 1 ? F.KVS : F.KVW)) + (size_t)r * 256;
                float* od;
                if (!smp) { const int b = r / SEQ, t = r % SEQ;
                    if (br == 0) od = F.out + O_CKP + (size_t)r * 256; else if (br == 1) od = F.out + O_SKP + (size_t)r * 256;
                    else od = t >= SEQ - 512 ? F.out + O_WKP + ((size_t)b * 512 + (t - (SEQ - 512))) * 256 : nullptr;
                } else { const int b = rr / TS, t = rr % TS;
                    if (br == 0) od = F.out + O_CKS + (size_t)rr * 256; else if (br == 1) od = F.out + O_SKS + (size_t)rr * 256;
                    else od = F.out + O_WKS + ((size_t)b * 512 + 504 + t) * 256;
                }
#pragma unroll
                for (int part = 0; part < 4; ++part) {
                    const float x = bf2f(zrow[8 + br * 4 + part]); float o = x;
                    if (part < 2) { const float ss = wave_sum(x * x); const float y = x * rsqrtf(ss * (1.f / 64.f) + EPS) * kg; const float pr = __shfl_xor(y, 32);
                        o = lane < 32 ? y * c - pr * s : y * c + pr * s; }
                    kvb[part * 64 + lane] = (bf16)f2bf(o);
                    if (od) od[part * 64 + lane] = o;
                    if (part >= 2 && br >= 1) vt[(br - 1) * 2 + (part - 2)][i % NR] = o;
                }
            }
            if (lane < 24) F.GATES[(size_t)r * 24 + lane] = sigm(bf2f(zrow[20]));
        }
#undef P2_LOAD
        if (NR == 8) { const int r0 = rfirst, b = r0 / SEQ, t0 = r0 % SEQ;
#pragma unroll
            for (int q = 0; q < 4; ++q) { v4u w; w.x = pkbf(vt[q][0], vt[q][1]); w.y = pkbf(vt[q][2 % NR], vt[q][3 % NR]); w.z = pkbf(vt[q][4 % NR], vt[q][5 % NR]); w.w = pkbf(vt[q][6 % NR], vt[q][7 % NR]);
                *(v4u*)((q < 2 ? F.VTS : F.VTW) + ((size_t)(b * 2 + (q & 1)) * 64 + lane) * SEQ + t0) = w; } }
    }
}
__device__ __forceinline__ void p2_features(const Frame& F) {
    const int gw = F.vcu * NWAVES + F.wave, NGW = F.G * NWAVES, lane = F.lane;
    const float qg = F.q_g[lane]; const float kg0 = F.k_g[lane], kg1 = F.k_g[64 + lane], kg2 = F.k_g[128 + lane];
    for (int rb = gw; rb < MP / 8; rb += NGW) p2_block<8>(F, rb * 8, lane, qg, kg0, kg1, kg2);
    for (int r = MP + gw; r < MT; r += NGW) p2_block<1>(F, r, lane, qg, kg0, kg1, kg2);
}

__device__ __forceinline__ void cmp_gemm_task(const Frame& F, int task, int lane) {
    const int nt = task & 7, t8 = task >> 3, seq = t8 >> 6, jg = (t8 >> 4) & 3, tile = t8 & 15;
    const int j = jg >> 1, c0 = tile * 16, Q = lane >> 4, fr = lane & 15;
    f32x4 acc[2] = {(f32x4){0.f, 0.f, 0.f, 0.f}, (f32x4){0.f, 0.f, 0.f, 0.f}};
    const bf16* ab = F.KVC + ((size_t)seq * SEQ + 16 * (c0 + fr)) * 256 + jg * 64 + 8 * Q;
    const bf16* wb = F.W1T + (size_t)(j * 128 + nt * 16 + fr) * 1024 + 8 * Q;
#pragma unroll 16
    for (int ks = 0; ks < 32; ++ks) {
        const bf16x8 B = *(const bf16x8*)(wb + ks * 32), A = *(const bf16x8*)(ab + (ks >> 1) * 256 + (ks & 1) * 32);
        acc[ks & 1] = __builtin_amdgcn_mfma_f32_16x16x32_bf16(A, B, acc[ks & 1], 0, 0, 0);
    }
    const f32x4 r = acc[0] + acc[1];
    float* pb = F.PBUF + ((size_t)jg * CROWS + crow_base(seq) + c0) * 128;
#pragma unroll
    for (int rg = 0; rg < 4; ++rg) pb[(size_t)(4 * Q + rg) * 128 + nt * 16 + fr] = r[rg];
}
__device__ __forceinline__ void cmp_tail_run(const Frame& F, int run, int lane) {
    int seq, jg, c0, nblk;
    if (run < 128) { seq = run >> 5; jg = (run >> 3) & 3; c0 = (run & 7) * 32; nblk = 255; } else { const int u = run - 128; seq = NBAT + (u >> 7); jg = (u >> 5) & 3; c0 = (u & 31) * 32; nblk = 1023; }
    const int j = jg >> 1, g = jg & 1;
    float w2r[64];
#pragma unroll
    for (int e = 0; e < 64; ++e) w2r[e] = F.cmp_w2[(size_t)j * 4096 + e * 64 + lane];
    const float cb = F.CBIAS[j * 64 + lane];
    const float* pb = F.PBUF + ((size_t)jg * CROWS + crow_base(seq)) * 128;
    bf16* dst = (j == 0 ? F.KC : F.VC) + ((size_t)g * CROWS + crow_base(seq)) * 64;
    bf16* dstT = F.VCT + ((size_t)g * 64 + lane) * CROWS + crow_base(seq);
    float pa[2][4], pc[2][4];
#define CT_LOAD(s_, cc_) do { _Pragma("unroll") for (int u = 0; u < 4; ++u) { const int c__ = (cc_) + u; pa[s_][u] = pb[(size_t)c__ * 128 + lane]; pc[s_][u] = pb[(size_t)(c__ + 1 < NCH_S ? c__ + 1 : c__) * 128 + 64 + lane]; } } while (0)
#define CT_STEP(s_, cc_) do { float o4[4]; _Pragma("unroll") for (int u = 0; u < 4; ++u) { const int c = (cc_) + u; const float sv = silu(cb + pa[s_][u] + pc[s_][u]); float o = 0.f; \
        _Pragma("unroll") for (int e = 0; e < 64; ++e) o += __int_as_float(__builtin_amdgcn_readlane(__float_as_int(sv), e)) * w2r[e]; \
        o = c < nblk ? o : 0.f; o4[u] = o; dst[(size_t)c * 64 + lane] = (bf16)f2bf(o); } \
        if (j == 1) { v2u w__; w__.x = pkbf(o4[0], o4[1]); w__.y = pkbf(o4[2], o4[3]); *(v2u*)(dstT + (cc_)) = w__; } } while (0)
    CT_LOAD(0, c0);
#pragma unroll 1
    for (int cc = c0; cc < c0 + 32; cc += 8) {
        CT_LOAD(1, cc + 4);
        CT_STEP(0, cc);
        if (cc + 8 < c0 + 32) CT_LOAD(0, cc + 8);
        CT_STEP(1, cc + 4);
    }
#undef CT_LOAD
#undef CT_STEP
}

__device__ __forceinline__ void cmp_tail_flat(const Frame& F, int w, int lane) {
    const int jg = w >> 9, wl = w & 511, j = jg >> 1, g = jg & 1;
    const int start = wl < 256 ? 68 * wl : 17408 + 64 * (wl - 256), nrows = wl < 256 ? 68 : 64;
    float w2r[64];
#pragma unroll
    for (int e = 0; e < 64; ++e) w2r[e] = F.cmp_w2[(size_t)j * 4096 + e * 64 + lane];
    const float cb = F.CBIAS[j * 64 + lane];
    const float* pb = F.PBUF + (size_t)jg * CROWS * 128;
    bf16* dst = (j == 0 ? F.KC : F.VC) + (size_t)g * CROWS * 64;
    bf16* dstT = F.VCT + ((size_t)g * 64 + lane) * CROWS;
    float pa[2][4], pc[2][4];
#define CT_LOAD(s_, cc_) do { _Pragma("unroll") for (int u = 0; u < 4; ++u) { const int c__ = (cc_) + u; pa[s_][u] = pb[(size_t)c__ * 128 + lane]; pc[s_][u] = pb[(size_t)(c__ + 1 < CROWS ? c__ + 1 : c__) * 128 + 64 + lane]; } } while (0)
#define CT_STEP(s_, cc_) do { float o4[4]; _Pragma("unroll") for (int u = 0; u < 4; ++u) { const int cr = (cc_) + u; const float sv = silu(cb + pa[s_][u] + pc[s_][u]); float o = 0.f; \
        _Pragma("unroll") for (int e = 0; e < 64; ++e) o += __int_as_float(__builtin_amdgcn_readlane(__float_as_int(sv), e)) * w2r[e]; \
        const bool keep = cr < NBAT * NCH_P ? ((cr & (NCH_P - 1)) < NCH_P - 1) : (((cr - NBAT * NCH_P) & (NCH_S - 1)) < NCH_S - 1);     \
        o = keep ? o : 0.f; o4[u] = o; dst[(size_t)cr * 64 + lane] = (bf16)f2bf(o); } \
        if (j == 1) { v2u w__; w__.x = pkbf(o4[0], o4[1]); w__.y = pkbf(o4[2], o4[3]); *(v2u*)(dstT + (cc_)) = w__; } } while (0)
    CT_LOAD(0, start);
#pragma unroll 1
    for (int cc = start; cc < start + nrows; cc += 8) {
        const bool two = cc + 4 < start + nrows;
        if (two) CT_LOAD(1, cc + 4);
        CT_STEP(0, cc);
        if (cc + 8 < start + nrows) CT_LOAD(0, cc + 8);
        if (two) CT_STEP(1, cc + 4);
    }
#undef CT_LOAD
#undef CT_STEP
}

__device__ __forceinline__ void cmp_tail_mfma(const Frame& F, int w, int lane) {
    const int jg = w >> 9, wl = w & 511, j = jg >> 1, g = jg & 1, fr = lane & 15, Q = lane >> 4;
    bf16x8 Bw[4][2];
#pragma unroll
    for (int nt = 0; nt < 4; ++nt)
#pragma unroll
        for (int ks = 0; ks < 2; ++ks) { float t[8];
#pragma unroll
            for (int i = 0; i < 8; ++i) t[i] = F.cmp_w2[(size_t)j * 4096 + (32 * ks + 8 * Q + i) * 64 + 16 * nt + fr];
            v4u u; u.x = pkbf(t[0], t[1]); u.y = pkbf(t[2], t[3]); u.z = pkbf(t[4], t[5]); u.w = pkbf(t[6], t[7]); Bw[nt][ks] = __builtin_bit_cast(bf16x8, u); }
    f32x4 cbv[4];
#pragma unroll
    for (int q = 0; q < 4; ++q) cbv[q] = *(const f32x4*)(F.CBIAS + j * 64 + 32 * (q >> 1) + 8 * Q + 4 * (q & 1));
    const float* pb = F.PBUF + (size_t)jg * CROWS * 128;
    bf16* dst = (j == 0 ? F.KC : F.VC) + (size_t)g * CROWS * 64;
    bf16* dstT = F.VCT + (size_t)g * 64 * CROWS;
    const bool five = wl < 64;
    f32x4 la[4][4], lc[4][4];
#define CM_TILE(i_) ((i_) < 4 ? 4 * wl + (i_) : 2048 + wl)
#define CM_LOAD(s_, tile_) do { const int r__ = (tile_) * 16 + fr, r1__ = r__ + 1 < CROWS ? r__ + 1 : r__; const float* pa__ = pb + (size_t)r__ * 128 + 8 * Q; const float* pc__ = pb + (size_t)r1__ * 128 + 64 + 8 * Q; \
        _Pragma("unroll") for (int q = 0; q < 4; ++q) { la[s_][q] = *(const f32x4*)(pa__ + 32 * (q >> 1) + 4 * (q & 1)); lc[s_][q] = *(const f32x4*)(pc__ + 32 * (q >> 1) + 4 * (q & 1)); } } while (0)
#define CM_STEP(s_, tile_) do { bf16x8 Af[2]; \
        _Pragma("unroll") for (int ks = 0; ks < 2; ++ks) { float sv[8]; \
            _Pragma("unroll") for (int i = 0; i < 8; ++i) { const int q = 2 * ks + (i >> 2); sv[i] = silu(cbv[q][i & 3] + la[s_][q][i & 3] + lc[s_][q][i & 3]); } \
            v4u u; u.x = pkbf(sv[0], sv[1]); u.y = pkbf(sv[2], sv[3]); u.z = pkbf(sv[4], sv[5]); u.w = pkbf(sv[6], sv[7]); Af[ks] = __builtin_bit_cast(bf16x8, u); } \
        const int cr0 = (tile_) * 16 + 4 * Q; bool keep[4]; \
        _Pragma("unroll") for (int rg = 0; rg < 4; ++rg) { const int cr = cr0 + rg; keep[rg] = cr < NBAT * NCH_P ? ((cr & (NCH_P - 1)) < NCH_P - 1) : (((cr - NBAT * NCH_P) & (NCH_S - 1)) < NCH_S - 1); }     \
        _Pragma("unroll") for (int nt = 0; nt < 4; ++nt) { f32x4 acc = (f32x4){0.f, 0.f, 0.f, 0.f}; \
            acc = __builtin_amdgcn_mfma_f32_16x16x32_bf16(Af[0], Bw[nt][0], acc, 0, 0, 0); acc = __builtin_amdgcn_mfma_f32_16x16x32_bf16(Af[1], Bw[nt][1], acc, 0, 0, 0); \
            _Pragma("unroll") for (int rg = 0; rg < 4; ++rg) { acc[rg] = keep[rg] ? acc[rg] : 0.f; dst[(size_t)(cr0 + rg) * 64 + 16 * nt + fr] = (bf16)f2bf(acc[rg]); } \
            if (j == 1) { v2u w__; w__.x = pkbf(acc[0], acc[1]); w__.y = pkbf(acc[2], acc[3]); *(v2u*)(dstT + (size_t)(16 * nt + fr) * CROWS + cr0) = w__; } } } while (0)
    CM_LOAD(0, CM_TILE(0)); CM_LOAD(1, CM_TILE(1)); CM_LOAD(2, CM_TILE(2)); CM_LOAD(3, CM_TILE(3));
    CM_STEP(0, CM_TILE(0));
    if (five) CM_LOAD(0, CM_TILE(4));
    CM_STEP(1, CM_TILE(1)); CM_STEP(2, CM_TILE(2)); CM_STEP(3, CM_TILE(3));
    if (five) CM_STEP(0, CM_TILE(4));
#undef CM_TILE
#undef CM_LOAD
#undef CM_STEP
}

constexpr int HG_QT = 0, HG_KT = 17408, HG_KHT = 34816, HG_VT = 53248, HG_AB = 71680, HG_TOT = 80896;
constexpr int HP = 136, HPT = 72;
__device__ __forceinline__ void hgrn_a_task(const Frame& F, int task) {
    const int tid = F.tid, lane = F.lane, wave = F.wave;
    const int h = task & 3, bn = task >> 2, r0 = bn * 64;
    LAS bf16* QT = (LAS bf16*)(F.lds + HG_QT); LAS bf16* KT = (LAS bf16*)(F.lds + HG_KT); LAS bf16* KHT = (LAS bf16*)(F.lds + HG_KHT);
    LAS bf16* VT = (LAS bf16*)(F.lds + HG_VT); LAS bf16* AB = (LAS bf16*)(F.lds + HG_AB); LAS float* TOT = (LAS float*)(F.lds + HG_TOT);
    const int k = tid & 127, tq = tid >> 7;
    const float lbk = F.LB[h * 128 + k];
    float lf[16], kb[16], qs[16];
    float run = 0.f;
#pragma unroll
    for (int i = 0; i < 16; ++i) { const int t = tq * 16 + i; const bf16* z = F.Z + (size_t)(r0 + t) * DINP + h * 128 + k;
        const float fz = bf2f(z[ZFB]); const float sg = sigm(fz); const float f = lbk + (1.f - lbk) * sg;
        run += __logf(f); lf[i] = run; kb[i] = (1.f - lbk) * (1.f - sg); qs[i] = silu(bf2f(z[ZQB]));
        VT[k * HPT + t] = z[ZIB]; }
    TOT[tq * 128 + k] = run;
    __syncthreads();
    const float t0 = TOT[k], t1 = TOT[128 + k], t2 = TOT[256 + k], t3 = TOT[384 + k];
    const float off = tq == 0 ? 0.f : (tq == 1 ? t0 : (tq == 2 ? t0 + t1 : t0 + t1 + t2));
    const float bref = t0 + t1, blast = (t0 + t1) + (t2 + t3);
#pragma unroll
    for (int i = 0; i < 16; ++i) { const int t = tq * 16 + i; const float b = off + lf[i];
        QT[t * HP + k] = (bf16)f2bf(qs[i] * __expf(b - bref));
        KT[t * HP + k] = (bf16)f2bf(kb[i] * __expf(bref - b));
        KHT[k * HPT + t] = (bf16)f2bf(kb[i] * __expf(blast - b));
        F.QI[(size_t)(r0 + t) * 512 + h * 128 + k] = (bf16)f2bf(qs[i] * __expf(b)); }
    if (tq == 0) F.DEC[(size_t)task * 128 + k] = __expf(blast);
    __syncthreads();
    const int fr = lane & 15, Q = lane >> 4;
    { const int mt = wave >> 1;
#pragma unroll
      for (int q = 0; q < 2; ++q) { const int nt = 2 * (wave & 1) + q; f32x4 acc = (f32x4){0.f, 0.f, 0.f, 0.f};
        if (nt <= mt) {
#pragma unroll
            for (int ks = 0; ks < 4; ++ks) { const bf16x8 a = *(const LAS bf16x8*)(QT + (16 * mt + fr) * HP + 32 * ks + 8 * Q); const bf16x8 b = *(const LAS bf16x8*)(KT + (16 * nt + fr) * HP + 32 * ks + 8 * Q);
                acc = __builtin_amdgcn_mfma_f32_16x16x32_bf16(a, b, acc, 0, 0, 0); } }
#pragma unroll
        for (int rg = 0; rg < 4; ++rg) { const int t = 16 * mt + 4 * Q + rg, s = 16 * nt + fr; AB[t * HPT + s] = (bf16)f2bf(s <= t ? acc[rg] : 0.f); } } }
    __syncthreads();
    { const int mt = wave >> 1;
#pragma unroll
      for (int q = 0; q < 4; ++q) { const int nt = 4 * (wave & 1) + q; f32x4 acc = (f32x4){0.f, 0.f, 0.f, 0.f};
#pragma unroll
        for (int ks = 0; ks < 2; ++ks) { const bf16x8 a = *(const LAS bf16x8*)(AB + (16 * mt + fr) * HPT + 32 * ks + 8 * Q); const bf16x8 b = *(const LAS bf16x8*)(VT + (16 * nt + fr) * HPT + 32 * ks + 8 * Q);
            acc = __builtin_amdgcn_mfma_f32_16x16x32_bf16(a, b, acc, 0, 0, 0); }
#pragma unroll
        for (int rg = 0; rg < 4; ++rg) ((bf16*)F.OI)[(size_t)(r0 + 16 * mt + 4 * Q + rg) * 512 + h * 128 + 16 * nt + fr] = (bf16)f2bf(acc[rg]); } }
    { const int mt = wave;
#pragma unroll
      for (int nt = 0; nt < 8; ++nt) { f32x4 acc = (f32x4){0.f, 0.f, 0.f, 0.f};
#pragma unroll
        for (int ks = 0; ks < 2; ++ks) { const bf16x8 a = *(const LAS bf16x8*)(KHT + (16 * mt + fr) * HPT + 32 * ks + 8 * Q); const bf16x8 b = *(const LAS bf16x8*)(VT + (16 * nt + fr) * HPT + 32 * ks + 8 * Q);
            acc = __builtin_amdgcn_mfma_f32_16x16x32_bf16(a, b, acc, 0, 0, 0); }
#pragma unroll
        for (int rg = 0; rg < 4; ++rg) ((bf16*)F.U)[((size_t)task * 128 + 16 * mt + 4 * Q + rg) * 128 + 16 * nt + fr] = (bf16)f2bf(acc[rg]); } }
    __syncthreads();
}
__device__ __forceinline__ void hgrn_scan(const Frame& F) {
    const int gt = F.vcu * NWAVES * 64 + F.tid, NGT = F.G * NWAVES * 64;
    for (int it = gt; it < 16 * 8192; it += NGT) {
        const int bh = it >> 13, e = it & 8191, k = e >> 6, v = (e & 63) * 2, b = bh >> 2, h = bh & 3;
        float s0 = 0.f, s1 = 0.f;
        float d[2][16]; unsigned uw[2][16];
#define HS_LOAD(s_, n0_) do { _Pragma("unroll") for (int j = 0; j < 16; ++j) { const int task = (b * 64 + (n0_) + j) * 4 + h; d[s_][j] = F.DEC[(size_t)task * 128 + k]; uw[s_][j] = *(const unsigned*)((const bf16*)F.U + ((size_t)task * 128 + k) * 128 + v); } } while (0)
#define HS_STEP(s_, n0_) do { _Pragma("unroll") for (int j = 0; j < 16; ++j) { const int task = (b * 64 + (n0_) + j) * 4 + h; *(unsigned*)(F.SP + ((size_t)task * 128 + k) * 128 + v) = pkbf(s0, s1); \
        s0 = d[s_][j] * s0 + bflo(uw[s_][j]); s1 = d[s_][j] * s1 + bfhi(uw[s_][j]); } } while (0)
        HS_LOAD(0, 0);
#pragma unroll 1
        for (int n0 = 0; n0 < 64; n0 += 32) { HS_LOAD(1, n0 + 16); HS_STEP(0, n0); if (n0 + 32 < 64) HS_LOAD(0, n0 + 32); HS_STEP(1, n0 + 16); }
#undef HS_LOAD
#undef HS_STEP
        *(f32x2*)(F.out + O_HP + ((size_t)bh * 128 + k) * 128 + v) = (f32x2){s0, s1};
    }
}
constexpr int HC_ST = 0, HC_OL = 34816, OLP = 132;
__device__ __forceinline__ void hgrn_c_task(const Frame& F, int task) {
    const int tid = F.tid, lane = F.lane, wave = F.wave;
    const int h = task & 3, bn = task >> 2, r0 = bn * 64;
    LAS bf16* ST = (LAS bf16*)(F.lds + HC_ST); LAS float* OL = (LAS float*)(F.lds + HC_OL);
    const int fr = lane & 15, Q = lane >> 4, mt = wave >> 1;
    unsigned w[16];
#pragma unroll
    for (int i = 0; i < 16; ++i) { const int e = tid + 512 * i, k = e >> 6, v = (e & 63) * 2; w[i] = *(const unsigned*)(F.SP + ((size_t)task * 128 + k) * 128 + v); }
    bf16x8 qa[4];
#pragma unroll
    for (int ks = 0; ks < 4; ++ks) qa[ks] = *(const bf16x8*)(F.QI + (size_t)(r0 + 16 * mt + fr) * 512 + h * 128 + 32 * ks + 8 * Q);
    bf16 oi[4][4];
#pragma unroll
    for (int q = 0; q < 4; ++q)
#pragma unroll
        for (int rg = 0; rg < 4; ++rg) oi[q][rg] = ((const bf16*)F.OI)[(size_t)(r0 + 16 * mt + 4 * Q + rg) * 512 + h * 128 + 16 * (4 * (wave & 1) + q) + fr];
    bf16 gz[8][2]; const float g0 = F.hgrn_g[lane], g1 = F.hgrn_g[64 + lane];
#pragma unroll
    for (int i = 0; i < 8; ++i) { const bf16* z = F.Z + (size_t)(r0 + wave * 8 + i) * DINP + ZGB + h * 128; gz[i][0] = z[lane]; gz[i][1] = z[64 + lane]; }
#pragma unroll
    for (int i = 0; i < 16; ++i) { const int e = tid + 512 * i, k = e >> 6, v = (e & 63) * 2; ST[v * HP + k] = (bf16)(w[i] & 0xffffu); ST[(v + 1) * HP + k] = (bf16)(w[i] >> 16); }
    __syncthreads();
#pragma unroll
    for (int q = 0; q < 4; ++q) { const int nt = 4 * (wave & 1) + q; f32x4 acc = (f32x4){0.f, 0.f, 0.f, 0.f};
#pragma unroll
        for (int ks = 0; ks < 4; ++ks) { const bf16x8 b = *(const LAS bf16x8*)(ST + (16 * nt + fr) * HP + 32 * ks + 8 * Q);
            acc = __builtin_amdgcn_mfma_f32_16x16x32_bf16(qa[ks], b, acc, 0, 0, 0); }
#pragma unroll
        for (int rg = 0; rg < 4; ++rg) { const int t = 16 * mt + 4 * Q + rg, v = 16 * nt + fr; OL[t * OLP + v] = acc[rg] + bf2f(oi[q][rg]); } }
    __syncthreads();
#pragma unroll
    for (int i = 0; i < 8; ++i) { const int t = wave * 8 + i; const float x0 = OL[t * OLP + lane], x1 = OL[t * OLP + 64 + lane];
        const float rs = rsqrtf(wave_sum(x0 * x0 + x1 * x1) * (1.f / 128.f) + EPS);
        bf16* ob = F.OB + (size_t)(r0 + t) * 512 + h * 128;
        ob[lane] = (bf16)f2bf(x0 * rs * g0 * silu(bf2f(gz[i][0])));
        ob[64 + lane] = (bf16)f2bf(x1 * rs * g1 * silu(bf2f(gz[i][1]))); }
    __syncthreads();
}
__device__ __forceinline__ void hgrn_sample_task(const Frame& F, int task) {
    const int tid = F.tid, b = task >> 2, h = task & 3, v = tid & 127, kq = tid >> 7;
    LAS float* L0 = (LAS float*)F.lds;
    float S[32];
    const float* s0 = F.st_hgrn + ((size_t)(b * 4 + h) * 128 + kq * 32) * 128 + v;
#pragma unroll
    for (int i = 0; i < 32; ++i) S[i] = s0[(size_t)i * 128];
    bf16 zf[TS], zq[TS], zi[TS], zg0[TS], zg1[TS];
    float hg0 = 0.f, hg1 = 0.f;
    if (tid < 128) {
#pragma unroll
        for (int t = 0; t < TS; ++t) { const bf16* z = F.Z + (size_t)(MP + b * TS + t) * DINP + h * 128; zf[t] = z[ZFB + tid]; zq[t] = z[ZQB + tid]; zi[t] = z[ZIB + tid]; } }
    if (tid < 64) { hg0 = F.hgrn_g[tid]; hg1 = F.hgrn_g[64 + tid];
#pragma unroll
        for (int t = 0; t < TS; ++t) { const bf16* z = F.Z + (size_t)(MP + b * TS + t) * DINP + h * 128; zg0[t] = z[ZGB + tid]; zg1[t] = z[ZGB + 64 + tid]; } }
    const float lbk = F.LB[h * 128 + (tid & 127)];
#pragma unroll
    for (int t = 0; t < TS; ++t) {
        const int r = MP + b * TS + t;
        LAS float* fL = L0 + (t & 1) * 1024; LAS float* kL = fL + 128; LAS float* qL = fL + 256; LAS float* vL = fL + 384; LAS float* red = fL + 512;
        if (tid < 128) { const float fz = bf2f(zf[t]);
            fL[tid] = lbk + (1.f - lbk) * sigm(fz); kL[tid] = (1.f - lbk) * sigm(-fz); qL[tid] = silu(bf2f(zq[t])); vL[tid] = bf2f(zi[t]); }
        __syncthreads();
        const float vv = vL[v]; float part = 0.f;
#pragma unroll
        for (int i = 0; i < 32; ++i) { const int kk = kq * 32 + i; S[i] = fL[kk] * S[i] + kL[kk] * vv; part += qL[kk] * S[i]; }
        red[kq * 128 + v] = part;
        __syncthreads();
        if (tid < 64) { const float o0 = (red[tid] + red[128 + tid]) + (red[256 + tid] + red[384 + tid]); const float o1 = (red[64 + tid] + red[192 + tid]) + (red[320 + tid] + red[448 + tid]);
            const float rs = rsqrtf(wave_sum(o0 * o0 + o1 * o1) * (1.f / 128.f) + EPS);
            bf16* ob = F.OB + (size_t)r * 512 + h * 128;
            ob[tid] = (bf16)f2bf(o0 * rs * hg0 * silu(bf2f(zg0[t])));
            ob[64 + tid] = (bf16)f2bf(o1 * rs * hg1 * silu(bf2f(zg1[t]))); }
    }
    __syncthreads();
    float* so = F.out + O_HS + ((size_t)(b * 4 + h) * 128 + kq * 32) * 128 + v;
#pragma unroll
    for (int i = 0; i < 32; ++i) so[(size_t)i * 128] = S[i];
}

__device__ __forceinline__ void p10_fix(const Frame& F) {
    const int gt = F.vcu * NWAVES * 64 + F.tid, NGT = F.G * NWAVES * 64;
    constexpr int CG4 = DFF / 4;
    const f32x4 z4 = (f32x4){0.f, 0.f, 0.f, 0.f};
    for (int it = gt; it < 576 * CG4; it += NGT) {
        const int idx = it / CG4, c = (it % CG4) * 4;
        const f32x4 a0 = *(const f32x4*)(F.RAW + (size_t)idx * 2 * DFF + c), bb = *(const f32x4*)(F.RAW + ((size_t)idx * 2 + 1) * DFF + c);
        f32x4 a1, a2; int r;
        if (idx < 512) { const int k = idx >> 1, i = idx & 1; r = 64 * k + i; const bool first = (k & 63) == 0;
            const f32x4 h0 = first ? z4 : *(const f32x4*)(F.HALO + (size_t)(2 * (k - 1)) * DFF + c), h1 = first ? z4 : *(const f32x4*)(F.HALO + (size_t)(2 * (k - 1) + 1) * DFF + c);
            if (i == 0) { a1 = h1; a2 = h0; } else { a1 = *(const f32x4*)(F.RAW + (size_t)(idx - 1) * 2 * DFF + c); a2 = h1; } }
        else { const int s = (idx - 512) >> 1, i = idx & 1; r = MP + TS * s + i;
            const f32x4 c0 = *(const f32x4*)(F.st_conv + ((size_t)s * 2) * DFF + c), c1 = *(const f32x4*)(F.st_conv + ((size_t)s * 2 + 1) * DFF + c);
            if (i == 0) { a1 = c1; a2 = c0; } else { a1 = *(const f32x4*)(F.RAW + (size_t)(idx - 1) * 2 * DFF + c); a2 = c1; } }
        const f32x4 cb = *(const f32x4*)(F.conv_b + c), w0 = *(const f32x4*)(F.conv_w + c), w1 = *(const f32x4*)(F.conv_w + DFF + c), w2 = *(const f32x4*)(F.conv_w + 2 * DFF + c);
        f32x4 g;
#pragma unroll
        for (int j = 0; j < 4; ++j) { const float cv = cb[j] + w0[j] * a2[j] + w1[j] * a1[j] + w2[j] * a0[j]; g[j] = silu(cv) * bb[j]; }
        v2u w; w.x = pkbf(g[0], g[1]); w.y = pkbf(g[2], g[3]); *(v2u*)(F.GB + (size_t)r * DFF + c) = w;
    }
    for (int it = gt; it < (NBAT * 2 + DECB * 2) * CG4; it += NGT) { const int q = it / CG4, c = (it % CG4) * 4;
        if (q < NBAT * 2) { const int bq = q >> 1, i = q & 1; *(f32x4*)(F.out + O_FCP + (size_t)q * DFF + c) = *(const f32x4*)(F.HALO + (size_t)(2 * (64 * bq + 63) + i) * DFF + c); }
        else { const int q2 = q - NBAT * 2; *(f32x4*)(F.out + O_FCS + (size_t)q2 * DFF + c) = *(const f32x4*)(F.HALO + (size_t)(512 + q2) * DFF + c); } }
}

__device__ __forceinline__ int cg2_addr(int row, int c) { return row * 2048 + ((c ^ (row & 15)) << 4); }
__device__ __forceinline__ void cmp_gemm_wg2(const Frame& F, int task, const int tid, const int lane, const int wave) {
    const int b = task >> 4, j = (task >> 3) & 1, eighth = task & 7, Q = lane >> 4, fr = lane & 15;
    LAS unsigned char* As = F.lds;
    bf16x8 Bf[32];
    { const bf16* wp = F.W1T + (size_t)(j * 128 + 16 * wave + fr) * 1024 + 8 * Q;
#pragma unroll
      for (int ks = 0; ks < 32; ++ks) Bf[ks] = *(const bf16x8*)(wp + 32 * ks); }
    const int p32 = tid & 31, rin = tid >> 5, gst = p32 >> 4;
    const unsigned loff = (unsigned)(j * 128 + 4 * p32 + rin * 256) * 4u;
    const char* cbase = (const char*)F.cache_cmp;
    const int ptv = F.ptab[b * NPG + eighth * 16 + (lane & 15)];
    const int wofs = rin * 8 + ((p32 & 15) >> 1), wsub = (p32 & 1) * 8;
    f32x4 st[2][8];
#define CG2_LOAD(g_, q_) do { const int pg = __builtin_amdgcn_readlane(ptv, (g_)); const char* ub__ = cbase + (size_t)pg * (PAGE * 1024); \
        _Pragma("unroll") for (int i = 0; i < 8; ++i) st[q_][i] = *(const f32x4*)(ub__ + i * 16384 + loff); } while (0)
#define CG2_WRITE(buf_, q_) do { _Pragma("unroll") for (int i = 0; i < 8; ++i) { v2u w; w.x = pkbf(st[q_][i].x, st[q_][i].y); w.y = pkbf(st[q_][i].z, st[q_][i].w); \
        *(LAS v2u*)(As + (buf_) * 32768 + cg2_addr(gst * 8 + i, wofs) + wsub) = w; } } while (0)
    CG2_LOAD(0, 0); CG2_LOAD(1, 1); CG2_WRITE(0, 0);
    asm volatile("s_waitcnt lgkmcnt(0)" ::: "memory"); __builtin_amdgcn_s_barrier(); asm volatile("" ::: "memory");
    CG2_LOAD(2, 0);
    float* pb = F.PBUF + ((size_t)(j * 2 + (Q >> 1)) * CROWS + crow_base(NBAT + b) + eighth * 128 + 4 * (Q & 1)) * 128 + 16 * wave + fr;
#define CG2_BODY(g, q_) do { \
        f32x4 acc = (f32x4){0.f, 0.f, 0.f, 0.f}; \
        const LAS unsigned char* ab = As + (q_) * 32768 + fr * 2048 + ((Q ^ (fr & 3)) << 4); \
        f32x4 acc1 = (f32x4){0.f, 0.f, 0.f, 0.f}; \
        _Pragma("unroll") \
        for (int ks = 0; ks < 32; ks += 2) { const bf16x8 A0 = *(const LAS bf16x8*)(ab + (((4 * ks) ^ (fr & 12)) << 4)), A1 = *(const LAS bf16x8*)(ab + (((4 * (ks + 1)) ^ (fr & 12)) << 4)); \
            acc = __builtin_amdgcn_mfma_f32_16x16x32_bf16(A0, Bf[ks], acc, 0, 0, 0); acc1 = __builtin_amdgcn_mfma_f32_16x16x32_bf16(A1, Bf[ks + 1], acc1, 0, 0, 0); } \
        acc = acc + acc1; \
        _Pragma("unroll") \
        for (int rg = 0; rg < 4; ++rg) pb[(size_t)((g) * 8 + rg) * 128] = acc[rg]; \
        if ((g) + 1 < 16) CG2_WRITE(1 - (q_), 1 - (q_)); \
        asm volatile("s_waitcnt lgkmcnt(0)" ::: "memory"); __builtin_amdgcn_s_barrier(); asm volatile("" ::: "memory"); \
        if ((g) + 3 < 16) CG2_LOAD((g) + 3, 1 - (q_)); } while (0)
#pragma unroll 1
    for (int g = 0; g < 16; g += 2) { CG2_BODY(g, 0); CG2_BODY(g + 1, 1); }
#undef CG2_BODY
#undef CG2_LOAD
#undef CG2_WRITE
}

constexpr float NEG_BIG = -1e30f, M_INIT = -1e20f;
__device__ __forceinline__ float qmax4(float v) { const auto a = __builtin_amdgcn_permlane16_swap(__float_as_uint(v), __float_as_uint(v), false, false); v = fmaxf(__uint_as_float(a[0]), __uint_as_float(a[1]));
    const auto b = __builtin_amdgcn_permlane32_swap(__float_as_uint(v), __float_as_uint(v), false, false); return fmaxf(__uint_as_float(b[0]), __uint_as_float(b[1])); }
__device__ __forceinline__ float qsum4(float v) { const auto a = __builtin_amdgcn_permlane16_swap(__float_as_uint(v), __float_as_uint(v), false, false); v = __uint_as_float(a[0]) + __uint_as_float(a[1]);
    const auto b = __builtin_amdgcn_permlane32_swap(__float_as_uint(v), __float_as_uint(v), false, false); return __uint_as_float(b[0]) + __uint_as_float(b[1]); }

__device__ __forceinline__ void nsa_batch(const char* kbase, const char* vbase, int stride, int koff, int voff, int f32src, int kidx, bool valid, const float (&q)[4], bool do_pv,
                                          float (&m)[4], float (&l)[4], float (&acc)[4], f32x4& pv, LAS f32x4* wl_p, LAS int* wl_idx, int lane) {
    float vv[64];
    if (do_pv) {
        if (!f32src) { const bf16* vb = (const bf16*)vbase + voff + lane;
#pragma unroll
            for (int jj = 0; jj < 64; ++jj) vv[jj] = bf2f(vb[(size_t)__builtin_amdgcn_readlane(kidx, jj) * stride]); }
        else { const float* vb = (const float*)vbase + voff + lane;
#pragma unroll
            for (int jj = 0; jj < 64; ++jj) vv[jj] = vb[(size_t)__builtin_amdgcn_readlane(kidx, jj) * stride]; }
    }
    float sc[4] = {0.f, 0.f, 0.f, 0.f};
    if (!f32src) { const v4u* kp = (const v4u*)(kbase + ((size_t)kidx * stride + koff) * 2);
#pragma unroll
        for (int c8 = 0; c8 < 8; ++c8) { const v4u w = kp[c8]; const float kv[8] = {bflo(w.x), bfhi(w.x), bflo(w.y), bfhi(w.y), bflo(w.z), bfhi(w.z), bflo(w.w), bfhi(w.w)};
#pragma unroll
            for (int e = 0; e < 8; ++e)
#pragma unroll
                for (int hh = 0; hh < 4; ++hh) sc[hh] += __int_as_float(__builtin_amdgcn_readlane(__float_as_int(q[hh]), c8 * 8 + e)) * kv[e]; } }
    else { const f32x4* kp = (const f32x4*)(kbase + ((size_t)kidx * stride + koff) * 4);
#pragma unroll
        for (int c4 = 0; c4 < 16; ++c4) { const f32x4 w = kp[c4];
#pragma unroll
            for (int e = 0; e < 4; ++e)
#pragma unroll
                for (int hh = 0; hh < 4; ++hh) sc[hh] += __int_as_float(__builtin_amdgcn_readlane(__float_as_int(q[hh]), c4 * 4 + e)) * w[e]; } }
#pragma unroll
    for (int hh = 0; hh < 4; ++hh) { const float sv = valid ? sc[hh] : -1e30f; const float mn = fmaxf(m[hh], wave_max(sv));
        const float p = valid ? ex2(sv - mn) : 0.f; const float al = ex2(m[hh] - mn);
        l[hh] = l[hh] * al + wave_sum(p); acc[hh] *= al; m[hh] = mn; pv[hh] = p; }
    if (do_pv) {
#pragma unroll
        for (int jj = 0; jj < 64; ++jj) {
#pragma unroll
            for (int hh = 0; hh < 4; ++hh) acc[hh] += __int_as_float(__builtin_amdgcn_readlane(__float_as_int(pv[hh]), jj)) * vv[jj]; }
    }
}
constexpr int SL_A = 0, SL_E = 272, SL_SC = 544, SL_SEL = 816, SL_WM = 832, SL_WL = 928, SL_WACC = 1024, SL_PW = 1024 + 6144, SL_END = SL_PW + 8 * 320;
constexpr int SW_MX = 832, SW_LS = 960, SW_OP = 1088, SW_PT = SW_OP + 8 * 256, SW_END = SW_PT + 128;
constexpr int SLOT_STRIDE = 4096;
__device__ __forceinline__ void nsa_sample_topk2(const Frame& F, const int tid, int rA, int rB, int g, LAS float* L) {
    const int slot = tid >> 8, s = tid & 255, r = slot ? rB : rA, rr = r - MP, bsm = rr / TS;
    LAS float* Ls = L + slot * SLOT_STRIDE;
    { const float im = F.IMPS[((size_t)rr * 2 + g) * 272 + s]; Ls[SL_SC + s] = ((s == 0) | (s == 255)) ? -3e38f : im; }
    if (s < NPG) ((LAS int*)(Ls + SW_PT))[s] = F.ptab[bsm * NPG + s];
    __syncthreads();
    if (s >= 1 && s <= 254) { const float my = Ls[SL_SC + s]; int cnt = 3;
        for (int s4 = 0; s4 < 64; ++s4) { const f32x4 o = *(LAS f32x4*)(Ls + SL_SC + 4 * s4);
#pragma unroll
            for (int e = 0; e < 4; ++e) cnt += ((o[e] > my) | ((o[e] == my) & (4 * s4 + e < s))) ? 1 : 0; }
        if (cnt < 16) ((LAS int*)(Ls + SL_SEL))[cnt] = s; }
    if (s == 0) { ((LAS int*)(Ls + SL_SEL))[0] = 0; ((LAS int*)(Ls + SL_SEL))[1] = 255; ((LAS int*)(Ls + SL_SEL))[2] = 256; }
    __syncthreads();
}
__device__ __forceinline__ void nsa_sample_wg(const Frame& F, const int tid, const int lane, const int wave, int r, int g, LAS float* L, const int slot) {
    const int rr = r - MP, bsm = rr / TS, t = rr - bsm * TS;
    const int fr = lane & 15, Q = lane >> 4, hq = fr & 3;
    LAS float* Lt = L + slot * SLOT_STRIDE;
    bf16x8 qf[2];
#pragma unroll
    for (int ks = 0; ks < 2; ++ks) qf[ks] = *(const bf16x8*)(F.QR + (size_t)r * 512 + (g * 4 + hq) * 64 + 32 * ks + 8 * Q);
    float g0 = 0.f, g1 = 0.f, g2 = 0.f, oc_ = 0.f, ow_ = 0.f;
    if (tid < 256) { const int hh = tid >> 6, d = tid & 63; const float* gp_ = F.GATES + (size_t)r * 24 + (g * 4 + hh) * 3; g0 = gp_[0]; g1 = gp_[1]; g2 = gp_[2];
        oc_ = F.OCS[(size_t)rr * 512 + (g * 4 + hh) * 64 + d]; ow_ = F.OWS[(size_t)rr * 512 + (g * 4 + hh) * 64 + d]; }
    const int s0 = __builtin_amdgcn_readfirstlane(((LAS int*)(Lt + SL_SEL))[2 * wave]), s1 = __builtin_amdgcn_readfirstlane(((LAS int*)(Lt + SL_SEL))[2 * wave + 1]);
    f32x4 vq[2][2][8];
#pragma unroll
    for (int kb = 0; kb < 1; ++kb) { const int s = kb ? s1 : s0;
        if (s < 256) { const float* base = F.cache_slc + ((size_t)__builtin_amdgcn_readfirstlane(((LAS int*)(Lt + SW_PT))[s >> 1]) * PAGE + (s & 1) * 64) * 256 + 128 + g * 64 + 4 * fr;
#pragma unroll
            for (int hf = 0; hf < 2; ++hf)
#pragma unroll
                for (int i = 0; i < 8; ++i) vq[kb][hf][i] = *(const f32x4*)(base + (size_t)(32 * hf + (i >> 2) * 16 + 4 * Q + (i & 3)) * 256); }
        else {
#pragma unroll
            for (int hf = 0; hf < 2; ++hf)
#pragma unroll
                for (int i = 0; i < 8; ++i) { const int kk = 32 * hf + (i >> 2) * 16 + 4 * Q + (i & 3);
                    const v2u w2 = *(const v2u*)(F.KVS + (size_t)(MP + bsm * TS + (kk < TS ? kk : TS - 1)) * 256 + 128 + g * 64 + 4 * fr);
                    vq[kb][hf][i] = (f32x4){bflo(w2.x), bfhi(w2.x), bflo(w2.y), bfhi(w2.y)}; } } }
    f32x4 S[2][2][2];
#pragma unroll
    for (int kb = 0; kb < 2; ++kb) { const int s = kb ? s1 : s0;
        if (s < 256) { const float* base = F.cache_slc + ((size_t)__builtin_amdgcn_readfirstlane(((LAS int*)(Lt + SW_PT))[s >> 1]) * PAGE + (s & 1) * 64) * 256 + g * 64 + 8 * Q;
#pragma unroll
            for (int hf = 0; hf < 2; ++hf)
#pragma unroll
                for (int sub = 0; sub < 2; ++sub) { const f32x4* kp = (const f32x4*)(base + (size_t)(32 * hf + 16 * sub + fr) * 256); const f32x4 a0 = kp[0], a1 = kp[1], b0 = kp[8], b1 = kp[9];
                    v4u w0, w1; w0.x = pkbf(a0.x, a0.y); w0.y = pkbf(a0.z, a0.w); w0.z = pkbf(a1.x, a1.y); w0.w = pkbf(a1.z, a1.w); w1.x = pkbf(b0.x, b0.y); w1.y = pkbf(b0.z, b0.w); w1.z = pkbf(b1.x, b1.y); w1.w = pkbf(b1.z, b1.w);
                    f32x4 a = (f32x4){0.f, 0.f, 0.f, 0.f}; a = __builtin_amdgcn_mfma_f32_16x16x32_bf16(__builtin_bit_cast(bf16x8, w0), qf[0], a, 0, 0, 0); a = __builtin_amdgcn_mfma_f32_16x16x32_bf16(__builtin_bit_cast(bf16x8, w1), qf[1], a, 0, 0, 0);
                    S[kb][hf][sub] = a; } }
        else {
#pragma unroll
            for (int hf = 0; hf < 2; ++hf)
#pragma unroll
                for (int sub = 0; sub < 2; ++sub) { const int jn = 32 * hf + 16 * sub + fr; const bf16* kp = F.KVS + (size_t)(MP + bsm * TS + (jn < TS ? jn : TS - 1)) * 256 + g * 64 + 8 * Q;
                    f32x4 a = (f32x4){0.f, 0.f, 0.f, 0.f}; a = __builtin_amdgcn_mfma_f32_16x16x32_bf16(*(const bf16x8*)kp, qf[0], a, 0, 0, 0); a = __builtin_amdgcn_mfma_f32_16x16x32_bf16(*(const bf16x8*)(kp + 32), qf[1], a, 0, 0, 0);
#pragma unroll
                    for (int rg = 0; rg < 4; ++rg) a[rg] = (32 * hf + 16 * sub + 4 * Q + rg <= t) ? a[rg] : NEG_BIG;
                    S[kb][hf][sub] = a; } } }
#pragma unroll
    for (int kb = 1; kb < 2; ++kb) { const int s = kb ? s1 : s0;
        if (s < 256) { const float* base = F.cache_slc + ((size_t)__builtin_amdgcn_readfirstlane(((LAS int*)(Lt + SW_PT))[s >> 1]) * PAGE + (s & 1) * 64) * 256 + 128 + g * 64 + 4 * fr;
#pragma unroll
            for (int hf = 0; hf < 2; ++hf)
#pragma unroll
                for (int i = 0; i < 8; ++i) vq[kb][hf][i] = *(const f32x4*)(base + (size_t)(32 * hf + (i >> 2) * 16 + 4 * Q + (i & 3)) * 256); }
        else {
#pragma unroll
            for (int hf = 0; hf < 2; ++hf)
#pragma unroll
                for (int i = 0; i < 8; ++i) { const int kk = 32 * hf + (i >> 2) * 16 + 4 * Q + (i & 3);
                    const v2u w2 = *(const v2u*)(F.KVS + (size_t)(MP + bsm * TS + (kk < TS ? kk : TS - 1)) * 256 + 128 + g * 64 + 4 * fr);
                    vq[kb][hf][i] = (f32x4){bflo(w2.x), bfhi(w2.x), bflo(w2.y), bfhi(w2.y)}; } } }
    { float m_ = M_INIT;
#pragma unroll
        for (int kb = 0; kb < 2; ++kb)
#pragma unroll
            for (int hf = 0; hf < 2; ++hf)
#pragma unroll
                for (int sub = 0; sub < 2; ++sub)
#pragma unroll
                    for (int rg = 0; rg < 4; ++rg) m_ = fmaxf(m_, S[kb][hf][sub][rg]);
        m_ = qmax4(m_); float l_ = 0.f;
#pragma unroll
        for (int kb = 0; kb < 2; ++kb)
#pragma unroll
            for (int hf = 0; hf < 2; ++hf)
#pragma unroll
                for (int sub = 0; sub < 2; ++sub)
#pragma unroll
                    for (int rg = 0; rg < 4; ++rg) l_ += ex2(S[kb][hf][sub][rg] - m_);
        l_ = qsum4(l_);
        if (Q == 0) { L[SW_MX + wave * 16 + fr] = m_; L[SW_LS + wave * 16 + fr] = l_; } }
    __syncthreads();
    float Mx = M_INIT;
#pragma unroll
    for (int w = 0; w < 8; ++w) Mx = fmaxf(Mx, L[SW_MX + w * 16 + fr]);
    f32x4 O[4];
#pragma unroll
    for (int dt = 0; dt < 4; ++dt) O[dt] = (f32x4){0.f, 0.f, 0.f, 0.f};
#pragma unroll
    for (int kb = 0; kb < 2; ++kb)
#pragma unroll
        for (int hf = 0; hf < 2; ++hf) { float p[2][4];
#pragma unroll
            for (int sub = 0; sub < 2; ++sub)
#pragma unroll
                for (int rg = 0; rg < 4; ++rg) p[sub][rg] = ex2(S[kb][hf][sub][rg] - Mx);
            v4u w; w.x = pkbf(p[0][0], p[0][1]); w.y = pkbf(p[0][2], p[0][3]); w.z = pkbf(p[1][0], p[1][1]); w.w = pkbf(p[1][2], p[1][3]); const bf16x8 pf = __builtin_bit_cast(bf16x8, w);
#pragma unroll
            for (int dt = 0; dt < 4; ++dt) { const f32x4 (&v8)[8] = vq[kb][hf];
                v4u u; u.x = pkbf(v8[0][dt], v8[1][dt]); u.y = pkbf(v8[2][dt], v8[3][dt]); u.z = pkbf(v8[4][dt], v8[5][dt]); u.w = pkbf(v8[6][dt], v8[7][dt]);
                O[dt] = __builtin_amdgcn_mfma_f32_16x16x32_bf16(__builtin_bit_cast(bf16x8, u), pf, O[dt], 0, 0, 0); } }
    if (fr < 4) {
#pragma unroll
        for (int dt = 0; dt < 4; ++dt)
#pragma unroll
            for (int rg = 0; rg < 4; ++rg) L[SW_OP + wave * 256 + (4 * (4 * Q + rg) + dt) * 4 + fr] = O[dt][rg]; }
    __syncthreads();
    if (tid < 256) { const int hh = tid >> 6, d = tid & 63; float M = M_INIT;
#pragma unroll
        for (int w = 0; w < 8; ++w) M = fmaxf(M, L[SW_MX + w * 16 + hh]);
        float Ls = 0.f, ob = 0.f;
#pragma unroll
        for (int w = 0; w < 8; ++w) { Ls += L[SW_LS + w * 16 + hh] * ex2(L[SW_MX + w * 16 + hh] - M); ob += L[SW_OP + w * 256 + d * 4 + hh]; }
        const float o = g0 * oc_ + g1 * ob / fmaxf(Ls, 1e-30f) + g2 * ow_;
        F.OA[(size_t)r * 512 + (g * 4 + hh) * 64 + d] = (bf16)f2bf(o); }
    __syncthreads();
}

constexpr int SC_WMX = 0, SC_WLS = 256, SC_MT = 512, SC_LT = 544, SC_A = 576, SC_E = SC_A + 8 * 272, SC_OP = SC_E + 8 * 272, SC_END = SC_OP + 8 * 2048;
__device__ __forceinline__ void nsa_sample_cmp(const Frame& F, int b, int g, const int tid, const int lane, const int wave, LAS float* L) {
    const int fr = lane & 15, Q = lane >> 4, tok = fr & 7, hsel = fr >> 3, crb = crow_base(NBAT + b), kb0 = 128 * wave;
    bf16x8 qf[2][2];
#pragma unroll
    for (int j = 0; j < 2; ++j)
#pragma unroll
        for (int ks = 0; ks < 2; ++ks) qf[j][ks] = *(const bf16x8*)(F.QR + (size_t)(MP + b * TS + tok) * 512 + (g * 4 + 2 * j + hsel) * 64 + 32 * ks + 8 * Q);
    const bf16* kp = F.KC + ((size_t)g * CROWS + crb + kb0 + fr) * 64 + 8 * Q;
    f32x4 S[4][2][2];
#pragma unroll
    for (int st = 0; st < 4; ++st)
#pragma unroll
        for (int sub = 0; sub < 2; ++sub) { const bf16x8 k0 = *(const bf16x8*)(kp + (size_t)(st * 32 + sub * 16) * 64), k1 = *(const bf16x8*)(kp + (size_t)(st * 32 + sub * 16) * 64 + 32);
#pragma unroll
            for (int j = 0; j < 2; ++j) { f32x4 a = (f32x4){0.f, 0.f, 0.f, 0.f}; a = __builtin_amdgcn_mfma_f32_16x16x32_bf16(k0, qf[j][0], a, 0, 0, 0); a = __builtin_amdgcn_mfma_f32_16x16x32_bf16(k1, qf[j][1], a, 0, 0, 0);
#pragma unroll
                for (int rg = 0; rg < 4; ++rg) if (kb0 + st * 32 + sub * 16 + 4 * Q + rg > 1022) a[rg] = NEG_BIG;
                S[st][sub][j] = a; } }
    float mx[2], ls[2];
#pragma unroll
    for (int j = 0; j < 2; ++j) { float m_ = NEG_BIG;
#pragma unroll
        for (int st = 0; st < 4; ++st)
#pragma unroll
            for (int sub = 0; sub < 2; ++sub)
#pragma unroll
                for (int rg = 0; rg < 4; ++rg) m_ = fmaxf(m_, S[st][sub][j][rg]);
        m_ = qmax4(m_); float l_ = 0.f;
#pragma unroll
        for (int st = 0; st < 4; ++st)
#pragma unroll
            for (int sub = 0; sub < 2; ++sub)
#pragma unroll
                for (int rg = 0; rg < 4; ++rg) l_ += ex2(S[st][sub][j][rg] - m_);
        l_ = qsum4(l_); mx[j] = m_; ls[j] = l_;
        if (Q == 0) { L[SC_WMX + (wave * 2 + j) * 16 + fr] = m_; L[SC_WLS + (wave * 2 + j) * 16 + fr] = l_; } }
    const bf16* vp = F.VCT + ((size_t)g * 64 + fr) * CROWS + crb + kb0 + 4 * Q;
    v2u vlo[4][4], vhi[4][4];
#pragma unroll
    for (int st = 0; st < 4; ++st)
#pragma unroll
        for (int dt = 0; dt < 4; ++dt) { vlo[st][dt] = *(const v2u*)(vp + (size_t)dt * 16 * CROWS + st * 32); vhi[st][dt] = *(const v2u*)(vp + (size_t)dt * 16 * CROWS + st * 32 + 16); }
    __syncthreads();
    float M[2], invl[2];
#pragma unroll
    for (int j = 0; j < 2; ++j) { float m_ = NEG_BIG;
#pragma unroll
        for (int w = 0; w < 8; ++w) m_ = fmaxf(m_, L[SC_WMX + (w * 2 + j) * 16 + fr]);
        float l_ = 0.f;
#pragma unroll
        for (int w = 0; w < 8; ++w) l_ += L[SC_WLS + (w * 2 + j) * 16 + fr] * ex2(L[SC_WMX + (w * 2 + j) * 16 + fr] - m_);
        M[j] = m_; invl[j] = 1.f / fmaxf(l_, 1e-30f);
        if (wave == 0 && Q == 0) L[SC_LT + j * 16 + fr] = invl[j]; }
    f32x4 O[2][4];
#pragma unroll
    for (int j = 0; j < 2; ++j)
#pragma unroll
        for (int dt = 0; dt < 4; ++dt) O[j][dt] = (f32x4){0.f, 0.f, 0.f, 0.f};
#pragma unroll
    for (int st = 0; st < 4; ++st) { bf16x8 pf[2]; float p[2][2][4];
#pragma unroll
        for (int j = 0; j < 2; ++j) {
#pragma unroll
            for (int sub = 0; sub < 2; ++sub)
#pragma unroll
                for (int rg = 0; rg < 4; ++rg) p[j][sub][rg] = ex2(S[st][sub][j][rg] - M[j]);
            v4u w; w.x = pkbf(p[j][0][0], p[j][0][1]); w.y = pkbf(p[j][0][2], p[j][0][3]); w.z = pkbf(p[j][1][0], p[j][1][1]); w.w = pkbf(p[j][1][2], p[j][1][3]); pf[j] = __builtin_bit_cast(bf16x8, w); }
#pragma unroll
        for (int sub = 0; sub < 2; ++sub) { float a = 0.f, e = 0.f;
#pragma unroll
            for (int j = 0; j < 2; ++j) { a += ((p[j][sub][0] + p[j][sub][1]) + (p[j][sub][2] + p[j][sub][3])) * invl[j]; e += p[j][sub][3] * invl[j]; }
            a += __shfl_xor(a, 8); e += __shfl_xor(e, 8);
            const int s_ = (kb0 + 32 * st + 16 * sub) / 4 + Q;
            if (hsel == 0) { L[SC_A + tok * 272 + s_] = a; L[SC_E + tok * 272 + s_] = e; } }
#pragma unroll
        for (int dt = 0; dt < 4; ++dt) { const v2u lo = vlo[st][dt], hi = vhi[st][dt];
            v4u w; w.x = lo.x; w.y = lo.y; w.z = hi.x; w.w = hi.y; const bf16x8 vf = __builtin_bit_cast(bf16x8, w);
#pragma unroll
            for (int j = 0; j < 2; ++j) O[j][dt] = __builtin_amdgcn_mfma_f32_16x16x32_bf16(vf, pf[j], O[j][dt], 0, 0, 0); } }
#pragma unroll
    for (int j = 0; j < 2; ++j)
#pragma unroll
        for (int dt = 0; dt < 4; ++dt)
#pragma unroll
            for (int rg = 0; rg < 4; ++rg) L[SC_OP + wave * 2048 + (16 * dt + 4 * Q + rg) * 32 + 16 * j + fr] = O[j][dt][rg];
    __syncthreads();
#pragma unroll
    for (int i = 0; i < 4; ++i) { const int idx = tid + 512 * i, d = idx >> 5, col = idx & 31; float o = 0.f;
#pragma unroll
        for (int w = 0; w < 8; ++w) o += L[SC_OP + w * 2048 + idx];
        const int tk = col & 7, hd = 2 * (col >> 4) + ((col >> 3) & 1);
        F.OCS[(size_t)(b * TS + tk) * 512 + (g * 4 + hd) * 64 + d] = o * L[SC_LT + col]; }
    for (int i = tid; i < 8 * 257; i += NWAVES * 64) { const int tk = i / 257, s_ = i % 257;
        F.IMPS[((size_t)(b * TS + tk) * 2 + g) * 272 + s_] = (s_ < 256 ? L[SC_A + tk * 272 + s_] : 0.f) + (s_ > 0 ? L[SC_E + tk * 272 + s_ - 1] : 0.f); }
    __syncthreads();
}

__device__ __forceinline__ void nsa_sample_win(const Frame& F, int b, int g, const int tid, const int lane, const int wave, LAS float* L) {
    const int fr = lane & 15, Q = lane >> 4, tok = fr & 7, hsel = fr >> 3;
    bf16x8 qf[2][2];
#pragma unroll
    for (int j = 0; j < 2; ++j)
#pragma unroll
        for (int ks = 0; ks < 2; ++ks) qf[j][ks] = *(const bf16x8*)(F.QR + (size_t)(MP + b * TS + tok) * 512 + (g * 4 + 2 * j + hsel) * 64 + 32 * ks + 8 * Q);
    const float* swb = F.st_win + (size_t)b * 512 * 256;
    f32x4 S[3][2][2];
#pragma unroll
    for (int k = 0; k < 3; ++k) { const int st = wave + 8 * k;
#pragma unroll
        for (int sub = 0; sub < 2; ++sub)
#pragma unroll
            for (int j = 0; j < 2; ++j) S[k][sub][j] = (f32x4){NEG_BIG, NEG_BIG, NEG_BIG, NEG_BIG};
        if (st < 17) {
#pragma unroll
            for (int sub = 0; sub < 2; ++sub) { bf16x8 k0, k1;
                if (st < 16) { const f32x4* kp = (const f32x4*)(swb + (size_t)(32 * st + 16 * sub + fr) * 256 + g * 64 + 8 * Q); const f32x4 a0 = kp[0], a1 = kp[1], b0 = kp[8], b1 = kp[9];
                    v4u w0, w1; w0.x = pkbf(a0.x, a0.y); w0.y = pkbf(a0.z, a0.w); w0.z = pkbf(a1.x, a1.y); w0.w = pkbf(a1.z, a1.w); w1.x = pkbf(b0.x, b0.y); w1.y = pkbf(b0.z, b0.w); w1.z = pkbf(b1.x, b1.y); w1.w = pkbf(b1.z, b1.w);
                    k0 = __builtin_bit_cast(bf16x8, w0); k1 = __builtin_bit_cast(bf16x8, w1); }
                else { const int jn = 16 * sub + fr; const bf16* kp = F.KVW + (size_t)(MP + b * TS + (jn < TS ? jn : TS - 1)) * 256 + g * 64 + 8 * Q; k0 = *(const bf16x8*)kp; k1 = *(const bf16x8*)(kp + 32); }
#pragma unroll
                for (int j = 0; j < 2; ++j) { f32x4 a = (f32x4){0.f, 0.f, 0.f, 0.f}; a = __builtin_amdgcn_mfma_f32_16x16x32_bf16(k0, qf[j][0], a, 0, 0, 0); a = __builtin_amdgcn_mfma_f32_16x16x32_bf16(k1, qf[j][1], a, 0, 0, 0);
#pragma unroll
                    for (int rg = 0; rg < 4; ++rg) { const int kk = 16 * sub + 4 * Q + rg; const bool ok = st < 16 ? (32 * st + kk >= tok + 1) : (kk <= tok); a[rg] = ok ? a[rg] : NEG_BIG; }
                    S[k][sub][j] = a; } } } }
    float Mx[2], invl[2];
#pragma unroll
    for (int j = 0; j < 2; ++j) { float m_ = NEG_BIG;
#pragma unroll
        for (int k = 0; k < 3; ++k)
#pragma unroll
            for (int sub = 0; sub < 2; ++sub)
#pragma unroll
                for (int rg = 0; rg < 4; ++rg) m_ = fmaxf(m_, S[k][sub][j][rg]);
        m_ = fmaxf(qmax4(m_), M_INIT); float l_ = 0.f;
#pragma unroll
        for (int k = 0; k < 3; ++k)
#pragma unroll
            for (int sub = 0; sub < 2; ++sub)
#pragma unroll
                for (int rg = 0; rg < 4; ++rg) l_ += ex2(S[k][sub][j][rg] - m_);
        l_ = qsum4(l_);
        if (Q == 0) { L[SC_WMX + (wave * 2 + j) * 16 + fr] = m_; L[SC_WLS + (wave * 2 + j) * 16 + fr] = l_; } }
    f32x4 vall[3][8];
#pragma unroll
    for (int k = 0; k < 3; ++k) { const int st = wave + 8 * k;
        if (st < 17) {
#pragma unroll
            for (int i = 0; i < 8; ++i) { const int kk = (i >> 2) * 16 + 4 * Q + (i & 3);
                if (st < 16) vall[k][i] = *(const f32x4*)(swb + (size_t)(32 * st + kk) * 256 + 128 + g * 64 + 4 * fr);
                else { const v2u w2 = *(const v2u*)(F.KVW + (size_t)(MP + b * TS + (kk < TS ? kk : TS - 1)) * 256 + 128 + g * 64 + 4 * fr); vall[k][i] = (f32x4){bflo(w2.x), bfhi(w2.x), bflo(w2.y), bfhi(w2.y)}; } } } }
    __syncthreads();
#pragma unroll
    for (int j = 0; j < 2; ++j) { float m_ = M_INIT;
#pragma unroll
        for (int w = 0; w < 8; ++w) m_ = fmaxf(m_, L[SC_WMX + (w * 2 + j) * 16 + fr]);
        float l_ = 0.f;
#pragma unroll
        for (int w = 0; w < 8; ++w) l_ += L[SC_WLS + (w * 2 + j) * 16 + fr] * ex2(L[SC_WMX + (w * 2 + j) * 16 + fr] - m_);
        Mx[j] = m_; invl[j] = 1.f / fmaxf(l_, 1e-30f);
        if (wave == 0 && Q == 0) L[SC_LT + j * 16 + fr] = invl[j]; }
    f32x4 O[2][4];
#pragma unroll
    for (int j = 0; j < 2; ++j)
#pragma unroll
        for (int dt = 0; dt < 4; ++dt) O[j][dt] = (f32x4){0.f, 0.f, 0.f, 0.f};
#pragma unroll
    for (int k = 0; k < 3; ++k) { const int st = wave + 8 * k;
        if (st < 17) { bf16x8 pf[2];
#pragma unroll
            for (int j = 0; j < 2; ++j) { float p[2][4];
#pragma unroll
                for (int sub = 0; sub < 2; ++sub)
#pragma unroll
                    for (int rg = 0; rg < 4; ++rg) p[sub][rg] = ex2(S[k][sub][j][rg] - Mx[j]);
                v4u w; w.x = pkbf(p[0][0], p[0][1]); w.y = pkbf(p[0][2], p[0][3]); w.z = pkbf(p[1][0], p[1][1]); w.w = pkbf(p[1][2], p[1][3]); pf[j] = __builtin_bit_cast(bf16x8, w); }
            const f32x4 (&v8q)[8] = vall[k];
#pragma unroll
            for (int dt = 0; dt < 4; ++dt) {
                v4u w; w.x = pkbf(v8q[0][dt], v8q[1][dt]); w.y = pkbf(v8q[2][dt], v8q[3][dt]); w.z = pkbf(v8q[4][dt], v8q[5][dt]); w.w = pkbf(v8q[6][dt], v8q[7][dt]); const bf16x8 vf = __builtin_bit_cast(bf16x8, w);
#pragma unroll
                for (int j = 0; j < 2; ++j) O[j][dt] = __builtin_amdgcn_mfma_f32_16x16x32_bf16(vf, pf[j], O[j][dt], 0, 0, 0); } } }
#pragma unroll
    for (int j = 0; j < 2; ++j)
#pragma unroll
        for (int dt = 0; dt < 4; ++dt)
#pragma unroll
            for (int rg = 0; rg < 4; ++rg) L[SC_OP + wave * 2048 + (4 * (4 * Q + rg) + dt) * 32 + 16 * j + fr] = O[j][dt][rg];
    __syncthreads();
#pragma unroll
    for (int i = 0; i < 4; ++i) { const int idx = tid + 512 * i, d = idx >> 5, col = idx & 31; float o = 0.f;
#pragma unroll
        for (int w = 0; w < 8; ++w) o += L[SC_OP + w * 2048 + idx];
        const int tk = col & 7, hd = 2 * (col >> 4) + ((col >> 3) & 1);
        F.OWS[(size_t)(b * TS + tk) * 512 + (g * 4 + hd) * 64 + d] = o * L[SC_LT + col]; }
    __syncthreads();
}

constexpr int NW_KBUF = 0, NW_VBUF = 16384, NW_UNI = 32768, NW_OACC = 33024, NW_END = NW_OACC + 65536;
static_assert(NW_END <= 131072, "nsa_wg LDS map");
__device__ __forceinline__ int nw_kaddr(int key, int c) { return (key >> 1) * 256 + ((((key & 1) * 8 + c) ^ ((key >> 1) & 15)) * 16); }
__device__ __forceinline__ int nw_vaddr(int d, int q) { return d * 64 + ((q ^ ((d >> 2) & 3)) * 16); }
struct NwStage { const bf16* src0; int mul; int w0, w1; bool kthr; };
struct NwReg { v4u a, b; };
__device__ __forceinline__ void nw_load(NwReg& r, const NwStage& st, int kb) { r.a = *(const v4u*)(st.src0 + (size_t)kb * st.mul); r.b = *(const v4u*)(st.src0 + (size_t)(kb + 32) * st.mul); }
__device__ __forceinline__ void nw_write(LAS unsigned char* L, int buf, const NwStage& st, const NwReg& r) {
    if (st.kthr) { *(LAS v4u*)(L + NW_KBUF + buf * 8192 + st.w0) = r.a; *(LAS v4u*)(L + NW_KBUF + buf * 8192 + 4096 + st.w0) = r.b; }
    else { *(LAS v2u*)(L + NW_VBUF + buf * 8192 + st.w0) = (v2u){r.a.x, r.a.y}; *(LAS v2u*)(L + NW_VBUF + buf * 8192 + st.w1) = (v2u){r.a.z, r.a.w};
           *(LAS v2u*)(L + NW_VBUF + buf * 8192 + 4096 + st.w0) = (v2u){r.b.x, r.b.y}; *(LAS v2u*)(L + NW_VBUF + buf * 8192 + 4096 + st.w1) = (v2u){r.b.z, r.b.w}; }
}
#define NW_BAR() do { asm volatile("s_waitcnt lgkmcnt(0)" ::: "memory"); __builtin_amdgcn_s_barrier(); asm volatile("" ::: "memory"); } while (0)
template <int MODE, int VAR>
__device__ __forceinline__ void nw_compute(LAS unsigned char* L, int buf, int kb0_, unsigned long long selm, int t, int tlast, int cvis,
                                           const bf16x8 (&qf)[2][2], const int (&kro)[2][2], const int (&vro)[4], float (&m)[2], float (&l)[2], f32x4 (&O)[2][4],
                                           const float (&invl)[2], LAS float* impw, float& eprev, int fr, int Q, int lane) {
#pragma unroll
      for (int hs = 0; hs < 2; ++hs) { const int kbh = kb0_ + 32 * hs;
        const bool active = MODE == 0 ? (kbh <= (tlast - 31) >> 4) : (kbh <= tlast);
        if (active) { const int kb = kbh;
            const LAS unsigned char* kbp = L + NW_KBUF + buf * 8192 + hs * 4096; const LAS unsigned char* vbp = L + NW_VBUF + buf * 8192 + hs * 4096;
            f32x4 S[2][2];
            __builtin_amdgcn_s_setprio(1);
#pragma unroll
            for (int sub = 0; sub < 2; ++sub) { const bf16x8 k0 = *(const LAS bf16x8*)(kbp + kro[sub][0]), k1 = *(const LAS bf16x8*)(kbp + kro[sub][1]);
#pragma unroll
                for (int h = 0; h < 2; ++h) { const float ini = (MODE != 0 && VAR == 0) ? -m[h] : 0.f; f32x4 a = (f32x4){ini, ini, ini, ini}; a = __builtin_amdgcn_mfma_f32_16x16x32_bf16(k0, qf[h][0], a, 0, 0, 0); a = __builtin_amdgcn_mfma_f32_16x16x32_bf16(k1, qf[h][1], a, 0, 0, 0); S[sub][h] = a; } }
            __builtin_amdgcn_s_setprio(0);
            const bool mine = MODE == 1 ? (bool)((selm >> (kb >> 6)) & 1ull) : true;
            const int tfirst = tlast - 15;
            const bool nomask = MODE == 0 ? (kb + 31 <= (tfirst - 31) >> 4) : (MODE == 1 ? (__all(mine) && kb + 31 <= tfirst) : (kb + 31 <= tfirst && kb + 512 > tlast));
            if (!nomask) {
#pragma unroll
            for (int sub = 0; sub < 2; ++sub)
#pragma unroll
                for (int rg = 0; rg < 4; ++rg) { const int kp = kb + sub * 16 + 4 * Q + rg;
                    const bool ok = MODE == 0 ? (kp <= cvis) : (MODE == 1 ? (mine & (kp <= t)) : ((kp <= t) & (kp + 512 > t)));
#pragma unroll
                    for (int h = 0; h < 2; ++h) S[sub][h][rg] = ok ? S[sub][h][rg] : NEG_BIG; }
            }
            if (VAR == 0) {
                bf16x8 pf[2];
#pragma unroll
                for (int h = 0; h < 2; ++h) { const f32x4 a = S[0][h], b = S[1][h];
                    float mn;
                    if (MODE == 0) { const float mx = qmax4(fmaxf(fmaxf(fmaxf(a[0], a[1]), fmaxf(a[2], a[3])), fmaxf(fmaxf(b[0], b[1]), fmaxf(b[2], b[3]))));
                        mn = fmaxf(m[h], mx); const float al = ex2(m[h] - mn); m[h] = mn; l[h] *= al;
#pragma unroll
                        for (int dt = 0; dt < 4; ++dt) O[h][dt] = O[h][dt] * al; }
                    else mn = 0.f;
                    const float p0 = ex2(a[0] - mn), p1 = ex2(a[1] - mn), p2 = ex2(a[2] - mn), p3 = ex2(a[3] - mn), p4 = ex2(b[0] - mn), p5 = ex2(b[1] - mn), p6 = ex2(b[2] - mn), p7 = ex2(b[3] - mn);
                    l[h] += ((p0 + p1) + (p2 + p3)) + ((p4 + p5) + (p6 + p7));
                    v4u w; w.x = pkbf(p0, p1); w.y = pkbf(p2, p3); w.z = pkbf(p4, p5); w.w = pkbf(p6, p7); pf[h] = __builtin_bit_cast(bf16x8, w); }
                __builtin_amdgcn_s_setprio(1);
#pragma unroll
                for (int dt = 0; dt < 4; ++dt) { const bf16x8 vf = *(const LAS bf16x8*)(vbp + vro[dt]);
#pragma unroll
                    for (int h = 0; h < 2; ++h) O[h][dt] = __builtin_amdgcn_mfma_f32_16x16x32_bf16(vf, pf[h], O[h][dt], 0, 0, 0); }
                __builtin_amdgcn_s_setprio(0);
            } else {
#pragma unroll
                for (int sub = 0; sub < 2; ++sub) { float a = 0.f, e = 0.f;
#pragma unroll
                    for (int rg = 0; rg < 4; ++rg)
#pragma unroll
                        for (int h = 0; h < 2; ++h) { const float pn = ex2(S[sub][h][rg] - m[h]) * invl[h]; a += pn; if (rg == 3) e += pn; }
                    const float up1 = __shfl(e, (lane + 48) & 63), up0 = __shfl(eprev, (lane + 48) & 63);
                    const int s = (kb >> 2) + sub * 4 + Q;
                    impw[fr * 64 + ((s + fr) & 63)] = a + (Q == 0 ? up0 : up1);
                    eprev = e; }
            }
        }
      }
}
template <int MODE, int VAR>
__device__ __forceinline__ void nw_run(LAS unsigned char* L, const NwStage& st, int kb0, int lim, unsigned long long U, unsigned long long selm, int t, int tlast, int cvis,
                                       const bf16x8 (&qf)[2][2], const int (&kro)[2][2], const int (&vro)[4], float (&m)[2], float (&l)[2], f32x4 (&O)[2][4],
                                       const float (&invl)[2], LAS float* impw, int fr, int Q, int lane) {
    if (kb0 > lim) return;
    NwReg r0, r1; nw_load(r0, st, kb0); r1 = r0;
    nw_write(L, 0, st, r0);
    NW_BAR();
    float eprev = 0.f;
    int buf = 0, kb = kb0, kb1 = kb0 + 64;
    if (MODE == 1) { while (kb1 <= lim && !((U >> (kb1 >> 6)) & 1ull)) kb1 += 64; }
    if (kb1 <= lim) nw_load(r0, st, kb1);
#define NW_STEP(RW, RL) { \
        int kb2 = kb1 + 64; \
        if (MODE == 1) { while (kb2 <= lim && !((U >> (kb2 >> 6)) & 1ull)) kb2 += 64; } \
        if (kb2 <= lim) nw_load(RL, st, kb2); \
        nw_compute<MODE, VAR>(L, buf, kb, selm, t, tlast, cvis, qf, kro, vro, m, l, O, invl, impw, eprev, fr, Q, lane); \
        if (kb1 <= lim) nw_write(L, buf ^ 1, st, RW); \
        NW_BAR(); \
        buf ^= 1; kb = kb1; kb1 = kb2; }
#pragma unroll 1
    for (;;) { NW_STEP(r0, r1) if (kb > lim) break; NW_STEP(r1, r0) if (kb > lim) break; }
#undef NW_STEP
}
template <bool FIRST> __device__ __forceinline__ void nw_finish(LAS float* wo, int lane, const float* gp, int br, float mreset, float (&m)[2], float (&l)[2], f32x4 (&O)[2][4]) {
#pragma unroll
    for (int h = 0; h < 2; ++h) { const float sc = gp[h * 3 + br] / fmaxf(qsum4(l[h]), 1e-30f);
#pragma unroll
        for (int dt = 0; dt < 4; ++dt)
#pragma unroll
            for (int rg = 0; rg < 4; ++rg) { volatile LAS float* p = wo + ((h * 4 + dt) * 4 + rg) * 64 + lane; const float v = O[h][dt][rg] * sc; *p = FIRST ? v : *p + v; }
        m[h] = mreset; l[h] = 0.f;
#pragma unroll
        for (int dt = 0; dt < 4; ++dt) O[h][dt] = (f32x4){0.f, 0.f, 0.f, 0.f}; }
}
__device__ __forceinline__ void nsa_wg_tile(const Frame& F, const int tid, const int lane, const int wave, int b, int g, int tile, LAS unsigned char* L) {
    const int fr = lane & 15, Q = lane >> 4, tg = wave >> 1, hp = wave & 1;
    const int T0 = tile * 64, t0 = T0 + 16 * tg, t = t0 + fr, tlast = t0 + 15, cur = tile;
    const size_t row0 = (size_t)b * SEQ; const int crb = b * NCH_P;
    bf16x8 qf[2][2];
#pragma unroll
    for (int h = 0; h < 2; ++h)
#pragma unroll
        for (int ks = 0; ks < 2; ++ks) qf[h][ks] = *(const bf16x8*)(F.QR + (row0 + t) * 512 + (g * 4 + 2 * hp + h) * 64 + 32 * ks + 8 * Q);
    const float* gp = F.GATES + (row0 + t) * 24 + (g * 4 + 2 * hp) * 3;
    int kro[2][2], vro[4];
#pragma unroll
    for (int sub = 0; sub < 2; ++sub)
#pragma unroll
        for (int ks = 0; ks < 2; ++ks) kro[sub][ks] = nw_kaddr(16 * sub + fr, 4 * ks + Q);
#pragma unroll
    for (int dt = 0; dt < 4; ++dt) vro[dt] = nw_vaddr(16 * dt + fr, Q);
    NwStage sC, sS, sW; const bool kthr = tid < 256; const int sk = tid >> 3, sc8 = tid & 7, sd = (tid & 255) >> 2, sp = tid & 3;
    sC.kthr = sS.kthr = sW.kthr = kthr;
    sC.w0 = sS.w0 = sW.w0 = kthr ? nw_kaddr(sk, sc8) : nw_vaddr(sd, 2 * (sp & 1)) + 8 * (sp >> 1);
    sC.w1 = sS.w1 = sW.w1 = nw_vaddr(sd, 2 * (sp & 1) + 1) + 8 * (sp >> 1);
    if (kthr) { sC.src0 = F.KC + ((size_t)g * CROWS + crb + sk) * 64 + 8 * sc8; sC.mul = 64;
                sS.src0 = F.KVS + (row0 + sk) * 256 + g * 64 + 8 * sc8; sS.mul = 256; sW.src0 = F.KVW + (row0 + sk) * 256 + g * 64 + 8 * sc8; sW.mul = 256; }
    else { sC.src0 = F.VCT + ((size_t)g * 64 + sd) * CROWS + crb + 8 * sp; sC.mul = 1;
           sS.src0 = F.VTS + ((size_t)(b * 2 + g) * 64 + sd) * SEQ + 8 * sp; sS.mul = 1; sW.src0 = F.VTW + ((size_t)(b * 2 + g) * 64 + sd) * SEQ + 8 * sp; sW.mul = 1; }
    LAS float* wo = (LAS float*)(L + NW_OACC + wave * 8192);
    LAS float* impw = (LAS float*)(L + NW_OACC + wave * 8192);
    float m[2] = {M_INIT, M_INIT}, l[2] = {0.f, 0.f}, invl[2] = {0.f, 0.f};
    f32x4 O[2][4];
#pragma unroll
    for (int h = 0; h < 2; ++h)
#pragma unroll
        for (int dt = 0; dt < 4; ++dt) O[h][dt] = (f32x4){0.f, 0.f, 0.f, 0.f};
    const int cvis = (t - 31) >> 4;
    const int clim = ((T0 + 63 - 31) >> 4) & ~63;
    nw_run<0, 0>(L, sC, 0, clim, 0ull, 0ull, t, tlast, cvis, qf, kro, vro, m, l, O, invl, impw, fr, Q, lane);
    unsigned long long selmask = ~0ull;
    if (cur >= 16) {
#pragma unroll
        for (int h = 0; h < 2; ++h) invl[h] = 1.f / fmaxf(qsum4(l[h]), 1e-30f);
        float mk[2] = {m[0], m[1]};
        nw_run<0, 1>(L, sC, 0, clim, 0ull, 0ull, t, tlast, cvis, qf, kro, vro, mk, l, O, invl, impw, fr, Q, lane);
        const LAS float* i0 = (const LAS float*)(L + NW_OACC + (tg * 2) * 8192); const LAS float* i1 = i0 + 2048;
        unsigned bits = 0;
#pragma unroll 1
        for (int half = 0; half < 2; ++half) {
            float my[8]; int cnt[8];
#pragma unroll
            for (int i = 0; i < 8; ++i) { const int s = 16 * Q + 8 * half + i; const bool forced = (s == 0) | (s == cur) | (s == cur - 1); const int a = fr * 64 + ((s + fr) & 63);
                my[i] = forced ? 1e4f : (s <= cur ? i0[a] + i1[a] : -1.f); cnt[i] = 0; }
#pragma unroll 1
            for (int s2 = 0; s2 <= cur; ++s2) { const bool forced2 = (s2 == 0) | (s2 >= cur - 1); const int a = fr * 64 + ((s2 + fr) & 63); const float o = forced2 ? 1e4f : i0[a] + i1[a];
#pragma unroll
                for (int i = 0; i < 8; ++i) cnt[i] += ((o > my[i]) | ((o == my[i]) & (s2 < 16 * Q + 8 * half + i))) ? 1 : 0; }
#pragma unroll
            for (int i = 0; i < 8; ++i) bits |= (cnt[i] < 16 ? 1u : 0u) << (8 * half + i);
        }
        unsigned lo = Q == 0 ? bits : (Q == 1 ? bits << 16 : 0u), hi = Q == 2 ? bits : (Q == 3 ? bits << 16 : 0u);
        lo |= __shfl_xor(lo, 16); lo |= __shfl_xor(lo, 32); hi |= __shfl_xor(hi, 16); hi |= __shfl_xor(hi, 32);
        selmask = ((unsigned long long)hi << 32) | lo;
    }
    unsigned ulo = (unsigned)selmask, uhi = (unsigned)(selmask >> 32);
#pragma unroll
    for (int o = 1; o < 16; o <<= 1) { ulo |= __shfl_xor(ulo, o); uhi |= __shfl_xor(uhi, o); }
    if (lane == 0) { ((LAS unsigned*)(L + NW_UNI))[wave * 2] = ulo; ((LAS unsigned*)(L + NW_UNI))[wave * 2 + 1] = uhi; }
    NW_BAR();
    unsigned long long U = 0ull;
#pragma unroll
    for (int w = 0; w < 8; ++w) U |= ((unsigned long long)((LAS unsigned*)(L + NW_UNI))[w * 2 + 1] << 32) | ((LAS unsigned*)(L + NW_UNI))[w * 2];
    U = ((unsigned long long)(unsigned)__builtin_amdgcn_readfirstlane((unsigned)(U >> 32)) << 32) | (unsigned)__builtin_amdgcn_readfirstlane((unsigned)U);
    const float m0 = F.M0[0];
    nw_finish<true>(wo, lane, gp, 0, m0, m, l, O);
    nw_run<1, 0>(L, sS, 0, T0 + 63, U, selmask, t, tlast, cvis, qf, kro, vro, m, l, O, invl, impw, fr, Q, lane);
    nw_finish<false>(wo, lane, gp, 1, m0, m, l, O);
    nw_run<2, 0>(L, sW, (T0 - 511 > 0 ? T0 - 511 : 0) & ~63, T0 + 63, 0ull, 0ull, t, tlast, cvis, qf, kro, vro, m, l, O, invl, impw, fr, Q, lane);
    nw_finish<false>(wo, lane, gp, 2, m0, m, l, O);
#pragma unroll
    for (int h = 0; h < 2; ++h)
#pragma unroll
        for (int dt = 0; dt < 4; ++dt) { volatile LAS float* p = wo + ((h * 4 + dt) * 4) * 64 + lane; v2u w; w.x = pk2(p[0], p[64]); w.y = pk2(p[128], p[192]);
            *(v2u*)(F.OA + (row0 + t) * 512 + (g * 4 + 2 * hp + h) * 64 + 16 * dt + 4 * Q) = w; }
    NW_BAR();
}

struct EpiSBranchA { float* T1; const bf16* Z;
    __device__ __forceinline__ f32x2 pre(int row, int col) const { return (f32x2){bf2f(Z[(size_t)row * DINP + ZMG + col]), 0.f}; }
    __device__ __forceinline__ void app(int row, int col, float v, f32x2 p) const { T1[(size_t)row * DM + col] = sigm(p.x) * v; } };
struct EpiSBranchB { const float* T1; bf16* MB; const bf16* Z;
    __device__ __forceinline__ f32x2 pre(int row, int col) const { return (f32x2){bf2f(Z[(size_t)row * DINP + ZMG + DM + col]), T1[(size_t)row * DM + col]}; }
    __device__ __forceinline__ void app(int row, int col, float v, f32x2 p) const { MB[(size_t)row * DM + col] = (bf16)f2bf(p.y + sigm(p.x) * v); } };
struct EpiSRes { const float* base; float* out;
    __device__ __forceinline__ f32x2 pre(int row, int col) const { return (f32x2){base[(size_t)row * DM + col], 0.f}; }
    __device__ __forceinline__ void app(int row, int col, float v, f32x2 p) const { out[(size_t)row * DM + col] = p.x + v; } };
template <int K, class EpiS> __device__ __forceinline__ void small_gemm(const Frame& F, const bf16* A, const bf16* Bt, const EpiS& E, const int tid, const int lane, const int wave) {
    constexpr int KW = K / 8;
    static_assert(KW % 32 == 0, "small_gemm: K/8 must be a multiple of 32");
    LAS float* red = (LAS float*)F.lds;
    const int fr = lane & 15, Q = lane >> 4;
    for (int task = F.vcu; task < 256; task += F.G) {
        const int rb = task >> 6, cb = task & 63;
        f32x2 pre_[2];
#pragma unroll
        for (int i = 0; i < 2; ++i) { const int e = tid + i * NWAVES * 64; pre_[i] = E.pre(MP + 64 * rb + (e >> 4), 16 * cb + (e & 15)); }
        f32x4 acc[4];
#pragma unroll
        for (int mt = 0; mt < 4; ++mt) acc[mt] = (f32x4){0.f, 0.f, 0.f, 0.f};
        const bf16* ap = A + (size_t)(MP + 64 * rb + fr) * K + wave * KW + 8 * Q;
        const bf16* bp = Bt + (size_t)(16 * cb + fr) * K + wave * KW + 8 * Q;
#pragma unroll
        for (int ks = 0; ks < KW / 32; ++ks) { const bf16x8 B = *(const bf16x8*)(bp + 32 * ks);
#pragma unroll
            for (int mt = 0; mt < 4; ++mt) { const bf16x8 Af = *(const bf16x8*)(ap + (size_t)mt * 16 * K + 32 * ks); acc[mt] = __builtin_amdgcn_mfma_f32_16x16x32_bf16(Af, B, acc[mt], 0, 0, 0); } }
#pragma unroll
        for (int mt = 0; mt < 4; ++mt)
#pragma unroll
            for (int rg = 0; rg < 4; ++rg) red[(wave * 64 + 16 * mt + 4 * Q + rg) * 16 + fr] = acc[mt][rg];
        __syncthreads();
#pragma unroll
        for (int i = 0; i < 2; ++i) { const int e = tid + i * NWAVES * 64; float s = 0.f;
#pragma unroll
            for (int w = 0; w < 8; ++w) s += red[w * 1024 + e];
            E.app(MP + 64 * rb + (e >> 4), 16 * cb + (e & 15), s, pre_[i]); }
        __syncthreads();
    }
}

__device__ __forceinline__ void small_gemm_rows(const Frame& F, const bf16* A, const bf16* Bt, const int tid, const int lane, const int wave) {
    constexpr int K = DM, KW = K / 8;
    LAS float* red = (LAS float*)F.lds;
    const int fr = lane & 15, Q = lane >> 4;
    for (int task = F.vcu; task < 256; task += F.G) {
        const int rb = task >> 4, cb = task & 15;
        f32x4 acc[4];
#pragma unroll
        for (int nt = 0; nt < 4; ++nt) acc[nt] = (f32x4){0.f, 0.f, 0.f, 0.f};
        const bf16* ap = A + (size_t)(MP + 16 * rb + fr) * K + wave * KW + 8 * Q;
        const bf16* bp = Bt + (size_t)(64 * cb + fr) * K + wave * KW + 8 * Q;
#pragma unroll
        for (int ks = 0; ks < KW / 32; ++ks) { const bf16x8 Af = *(const bf16x8*)(ap + 32 * ks);
#pragma unroll
            for (int nt = 0; nt < 4; ++nt) { const bf16x8 B = *(const bf16x8*)(bp + (size_t)nt * 16 * K + 32 * ks); acc[nt] = __builtin_amdgcn_mfma_f32_16x16x32_bf16(Af, B, acc[nt], 0, 0, 0); } }
#pragma unroll
        for (int nt = 0; nt < 4; ++nt)
#pragma unroll
            for (int rg = 0; rg < 4; ++rg) red[(wave * 16 + 4 * Q + rg) * 64 + 16 * nt + fr] = acc[nt][rg];
        float xin_[2], gin_[2];
#pragma unroll
        for (int i = 0; i < 2; ++i) { const int e = tid + i * NWAVES * 64, row = e >> 6, col = e & 63; const int grow = MP + 16 * rb + row, gcol = 64 * cb + col;
            xin_[i] = F.xs[(size_t)(grow - MP) * DM + gcol]; gin_[i] = F.ffn_g[gcol]; }
        __syncthreads();
#pragma unroll
        for (int i = 0; i < 2; ++i) { const int e = tid + i * NWAVES * 64, row = e >> 6, col = e & 63; float s = 0.f;
#pragma unroll
            for (int w = 0; w < 8; ++w) s += red[w * 1024 + e];
            const int grow = MP + 16 * rb + row, gcol = 64 * cb + col;
            const float x1 = xin_[i] + s; F.X1[(size_t)grow * DM + gcol] = x1; F.H[(size_t)grow * DM + gcol] = (bf16)f2bf(x1 * gin_[i]);
            const float ss = wave_sum(x1 * x1); if (lane == 0) F.SSP[(size_t)grow * 16 + cb] = ss; }
        __syncthreads();
    }
}

#ifndef MK_ONE_LAUNCH
#define MK_ONE_LAUNCH 0
#endif
constexpr int N_PHASES = 12;
struct Args { const float* in[24]; float* out; unsigned char* ws; int ph_lo, ph_hi; };
__global__ void __launch_bounds__(NWAVES * 64, 2) fwd(Args args) {
    extern __shared__ __attribute__((aligned(16))) unsigned char lds[];
    Frame F;
    F.lds = (LAS unsigned char*)lds;
    F.tid = threadIdx.x; F.lane = F.tid & 63; F.wave = __builtin_amdgcn_readfirstlane(F.tid >> 6);
    F.G = gridDim.x; { const int bx = blockIdx.x; F.vcu = (F.G % 8 == 0) ? (bx % 8) * (F.G / 8) + bx / 8 : bx; }
    unsigned char* ws = args.ws;
    F.xp = args.in[0]; F.xs = args.in[1]; F.cache_cmp = args.in[2]; F.cache_slc = args.in[3]; F.ptab = (const int*)args.in[4]; F.st_win = args.in[5]; F.st_hgrn = args.in[6]; F.st_conv = args.in[7];
    F.attn_g = args.in[8]; F.w_in = args.in[9]; F.q_g = args.in[10]; F.k_g = args.in[11]; F.pos_emb = args.in[12]; F.cmp_w1 = args.in[13]; F.cmp_w2 = args.in[14]; F.lb_logits = args.in[15];
    F.hgrn_g = args.in[16]; F.w_branch = args.in[17]; F.w_out = args.in[18]; F.ffn_g = args.in[19]; F.ffn_w_in = args.in[20]; F.conv_w = args.in[21]; F.conv_b = args.in[22]; F.ffn_w_out = args.in[23];
    F.out = args.out;
    F.WIN = (bf16*)(ws + WS_WIN); F.WBA = (bf16*)(ws + WS_WBA); F.WBB = (bf16*)(ws + WS_WBB); F.WOUT = (bf16*)(ws + WS_WOUT); F.WFIN = (bf16*)(ws + WS_WFIN); F.WFOUT = (bf16*)(ws + WS_WFOUT); F.W1T = (bf16*)(ws + WS_W1T);
    F.H = (bf16*)(ws + WS_H); F.Z = (bf16*)(ws + WS_Z); F.QR = (bf16*)(ws + WS_QR); F.KVC = (bf16*)(ws + WS_KVC); F.KVS = (bf16*)(ws + WS_KVS); F.KVW = (bf16*)(ws + WS_KVW);
    F.KC = (bf16*)(ws + WS_KC); F.VC = (bf16*)(ws + WS_VC); F.VCT = (bf16*)(ws + WS_VCT); F.VTS = (bf16*)(ws + WS_VTS); F.VTW = (bf16*)(ws + WS_VTW); F.SP = (bf16*)(ws + WS_SP); F.QI = (bf16*)(ws + WS_QI); F.OA = (bf16*)(ws + WS_OA); F.OB = (bf16*)(ws + WS_OB); F.MB = (bf16*)(ws + WS_MB); F.GB = (bf16*)(ws + WS_G);
    F.ROPE = (float*)(ws + WS_ROPE); F.LB = (float*)(ws + WS_LB); F.CBIAS = (float*)(ws + WS_CBIAS); F.M0 = (float*)(ws + WS_M0); F.RAW = (float*)(ws + WS_RAW); F.HALO = (float*)(ws + WS_HALO); F.SSP = (float*)(ws + WS_SSP); F.OCS = (float*)(ws + WS_OCS); F.IMPS = (float*)(ws + WS_IMPS); F.OWS = (float*)(ws + WS_OWS); F.GATES = (float*)(ws + WS_GATES); F.PBUF = (float*)(ws + WS_PBUF); F.U = (float*)(ws + WS_U); F.OI = (float*)(ws + WS_OI);
    F.DEC = (float*)(ws + WS_DEC); F.T1 = (float*)(ws + WS_T1); F.X1 = (float*)(ws + WS_X1);
    for (int u = F.tid; u < (LDS_BYTES - LDSCTL_OFF) / 4; u += NWAVES * 64) ((LAS unsigned*)(F.lds + LDSCTL_OFF))[u] = 0u;
    __syncthreads();
    volatile LAS unsigned* MISC = (volatile LAS unsigned*)(F.lds + MISC_OFF);
    unsigned* barw = (unsigned*)(ws + WS_CTL) + CW_BAR;
    XcdBarrier bar; bar.bar = barw; bar.x = 0; bar.st = nullptr;
    if (MK_ONE_LAUNCH) bar = xcd_barrier_post(barw, MISC + 8);
    const int lo = args.ph_lo, hi = args.ph_hi;
#define IN(k) (lo <= (k) && (k) < hi)
#ifndef DOUBLE_MASK
#define DOUBLE_MASK 0
#endif
#define XDONE_SIGNAL(n_) do { if (MK_ONE_LAUNCH) { asm volatile("s_waitcnt vmcnt(0)" ::: "memory"); __syncthreads(); \
    if (F.tid == 0) { __builtin_amdgcn_fence(__ATOMIC_RELEASE, "agent"); asm volatile("s_waitcnt vmcnt(0)" ::: "memory"); (void)xb_add(&barw[CW_XDONE - CW_BAR], (n_)); } } } while (0)
#define DBL(k) (((DOUBLE_MASK) >> (k)) & 1)
#define SEAM(k) do { if (MK_ONE_LAUNCH && IN(k) && IN((k) + 1)) { REFRESH(); xcd_barrier(bar, F.tid); if (DBL(20)) { REFRESH(); xcd_barrier(bar, F.tid); } } } while (0)
#define REFRESH() do { int l_ = (int)__builtin_amdgcn_mbcnt_hi(~0u, __builtin_amdgcn_mbcnt_lo(~0u, 0u)); asm volatile("" : "+v"(l_)); F.lane = l_; F.tid = F.wave * 64 + l_; } while (0)
    const int gw = F.vcu * NWAVES + F.wave, NGW = F.G * NWAVES;
    LAS unsigned char* ring = F.lds + RING_OFF;

    if (IN(0)) { for (int rep_ = 0; rep_ < 1 + DBL(0); ++rep_) { REFRESH(); p0_prologue(F); } SEAM(0); }
    if (IN(1)) { for (int rep_ = 0; rep_ < 1 + DBL(1); ++rep_) { REFRESH();
        pg8::Gemm g{F.H, F.WIN, MT, DINP, DM}; pg8::StaticOrder S; S.init(MT, DINP, F.G, (int)blockIdx.x);
        pg8::EpiBf16<0> E{F.Z, DINP, nullptr, 0, 0, 1.f};
        if (((F.vcu >> 5) & 1) == 0) { for (int r3_ = 0; r3_ < 1 + DBL(24); ++r3_) for (int task = F.vcu; task < 512; task += F.G) { REFRESH(); cmp_gemm_wg2(F, task, F.tid, F.lane, F.wave); } __syncthreads(); REFRESH(); }
        pg8::gemm_phase<pg8::EpiBf16<0>, pg8::StaticOrder, true, true>(ring, g, S, E, F.tid);
        if (((F.vcu >> 5) & 1) == 1) { __syncthreads(); for (int r3_ = 0; r3_ < 1 + DBL(24); ++r3_) for (int task = F.vcu; task < 512; task += F.G) { REFRESH(); cmp_gemm_wg2(F, task, F.tid, F.lane, F.wave); } __syncthreads(); }
        } SEAM(1);
    }
    if (IN(2)) { for (int rep_ = 0; rep_ < 1 + DBL(2); ++rep_) { REFRESH(); p2_features(F); } SEAM(2); }
    if (IN(3)) { for (int rep_ = 0; rep_ < 1 + DBL(3); ++rep_) { REFRESH();
        for (int r2_ = 0; r2_ < 1 + DBL(15); ++r2_) for (int task = F.vcu; task < 1024; task += F.G) { REFRESH(); hgrn_a_task(F, task); }
        REFRESH();
        for (int task = gw; task < 2048; task += NGW) cmp_gemm_task(F, task, F.lane);
        } SEAM(3);
    }
    if (IN(4)) { for (int rep_ = 0; rep_ < 1 + DBL(4); ++rep_) { REFRESH();
        for (int r2_ = 0; r2_ < 1 + DBL(17); ++r2_) hgrn_scan(F);
        for (int r2_ = 0; r2_ < 1 + DBL(18); ++r2_) { if (NGW == 2048) cmp_tail_mfma(F, gw, F.lane); else for (int run = gw; run < 128 + 4096; run += NGW) cmp_tail_run(F, run, F.lane); }
        } SEAM(4);
    }
    if (IN(5)) { for (int rep_ = 0; rep_ < 1 + DBL(5); ++rep_) { REFRESH();
        { const bool xw_ = (F.vcu & 3) == 0; const int xi_ = F.vcu >> 2, ni_ = (F.vcu >> 2) * 3 + (F.vcu & 3) - 1;
          const bool late_ = MK_ONE_LAUNCH && F.G == 256 && (((F.vcu & 3) == 1) || ((F.vcu & 7) == 3)); const int grp_ = F.vcu & 1;
#pragma unroll 1
          for (int step_ = 0; step_ < 5; ++step_) {
            const int kind_ = !late_ ? (step_ == 0 ? 0 : (step_ == 1 ? 1 : (step_ == 2 ? (grp_ == 0 ? 3 : 4) : (step_ == 3 ? 2 : (grp_ == 1 ? 3 : 4)))))
                                     : (step_ == 0 ? 1 : (step_ == 1 ? 0 : (step_ == 2 ? 4 : (step_ == 3 ? 2 : 3))));
            if (kind_ == 0) {
            if (F.G == 256) {
                if (xw_) { REFRESH(); nsa_sample_cmp(F, xi_ >> 1, xi_ & 1, F.tid, F.lane, F.wave, (LAS float*)ring); REFRESH(); nsa_sample_win(F, xi_ >> 1, xi_ & 1, F.tid, F.lane, F.wave, (LAS float*)ring); XDONE_SIGNAL(1u); }
                if (!xw_) { for (int k_ = 0; k_ < 6; ++k_) { const int task = ni_ + 192 * k_; REFRESH(); if (task < 1024) hgrn_c_task(F, task); else hgrn_sample_task(F, task - 1024); } }
            } else {
                for (int id = F.vcu; id < 64; id += F.G) { REFRESH(); nsa_sample_cmp(F, id >> 1, id & 1, F.tid, F.lane, F.wave, (LAS float*)ring); REFRESH(); nsa_sample_win(F, id >> 1, id & 1, F.tid, F.lane, F.wave, (LAS float*)ring); XDONE_SIGNAL(1u); }
                for (int task = F.vcu; task < 1024 + 128; task += F.G) { REFRESH(); if (task < 1024) hgrn_c_task(F, task); else hgrn_sample_task(F, task - 1024); }
            }
            } else if (kind_ == 1 || kind_ == 2) {
                for (int task = F.vcu; task < 256; task += F.G) { const int bg = task >> 5, jj = task & 31;
                    REFRESH(); nsa_wg_tile(F, F.tid, F.lane, F.wave, bg >> 1, bg & 1, kind_ == 1 ? 63 - jj : jj, ring); }
            } else if (kind_ == 3) {
                if (MK_ONE_LAUNCH) { if (F.tid == 0) { XB_SPIN(xb_ld(&barw[CW_XDONE - CW_BAR]) < 64u, barw); __builtin_amdgcn_fence(__ATOMIC_ACQUIRE, "agent"); asm volatile("s_waitcnt vmcnt(0)" ::: "memory"); } __syncthreads(); }
                if (F.G == 256) { const int rA_ = MP + (F.vcu >> 1), rB_ = MP + ((F.vcu + 256) >> 1), g_ = F.vcu & 1;
                    REFRESH(); nsa_sample_topk2(F, F.tid, rA_, rB_, g_, (LAS float*)ring);
                    REFRESH(); nsa_sample_wg(F, F.tid, F.lane, F.wave, rA_, g_, (LAS float*)ring, 0);
                    REFRESH(); nsa_sample_wg(F, F.tid, F.lane, F.wave, rB_, g_, (LAS float*)ring, 1); }
                else for (int id = F.vcu; id < 2 * MS; id += F.G) { REFRESH(); nsa_sample_topk2(F, F.tid, MP + (id >> 1), MP + (id >> 1), id & 1, (LAS float*)ring); REFRESH(); nsa_sample_wg(F, F.tid, F.lane, F.wave, MP + (id >> 1), id & 1, (LAS float*)ring, 0); }
            }
            __syncthreads(); REFRESH(); } }
        } SEAM(5);
    }
    if (IN(6)) { for (int rep_ = 0; rep_ < 1 + DBL(6); ++rep_) { REFRESH();
        { const bool sf_ = MK_ONE_LAUNCH && (F.vcu & 1);
#pragma unroll 1
          for (int part_ = 0; part_ < 2; ++part_) {
            if ((part_ == 0) == sf_) { REFRESH();
                small_gemm<512>(F, F.OA, F.WBA, EpiSBranchA{F.T1, F.Z}, F.tid, F.lane, F.wave);
                small_gemm<512>(F, F.OB, F.WBB, EpiSBranchB{F.T1, F.MB, F.Z}, F.tid, F.lane, F.wave); }
            else {
                { pg8::Gemm g{F.OA, F.WBA, MP, DM, 512}; pg8::StaticOrder S; S.init(MP, DM, F.G, (int)blockIdx.x);
                  pg8::EpiBranch<0> E{(bf16*)F.T1, F.MB, F.Z, DINP, ZMG, DM};
                  pg8::gemm_phase<pg8::EpiBranch<0>, pg8::StaticOrder, true, true>(ring, g, S, E, F.tid); }
                { pg8::Gemm g{F.OB, F.WBB, MP, DM, 512}; pg8::StaticOrder S; S.init(MP, DM, F.G, (int)blockIdx.x);
                  pg8::EpiBranch<1> E{(bf16*)F.T1, F.MB, F.Z, DINP, ZMG + DM, DM};
                  pg8::gemm_phase<pg8::EpiBranch<1>, pg8::StaticOrder, true, true>(ring, g, S, E, F.tid); } }
            __syncthreads(); REFRESH(); } }
        } SEAM(6);
    }
    if (IN(7)) { for (int rep_ = 0; rep_ < 1 + DBL(7); ++rep_) { REFRESH();
        pg8::Gemm g{F.MB, F.WOUT, MP, DM, DM}; pg8::StaticOrder S; S.init(MP, DM, F.G, (int)blockIdx.x);
        pg8::EpiResNorm E{F.xp, F.X1, F.H, F.ffn_g, F.SSP, DM};
        { const bool sf_ = MK_ONE_LAUNCH && (F.vcu & 1);
#pragma unroll 1
          for (int part_ = 0; part_ < 2; ++part_) {
            if ((part_ == 0) == sf_) { REFRESH(); small_gemm_rows(F, F.MB, F.WOUT, F.tid, F.lane, F.wave); }
            else pg8::gemm_phase<pg8::EpiResNorm, pg8::StaticOrder, true, true>(ring, g, S, E, F.tid);
            __syncthreads(); REFRESH(); } }
        } if (MK_ONE_LAUNCH && IN(7) && IN(9)) { REFRESH(); xcd_barrier(bar, F.tid); }
    }
    if (IN(9)) { for (int rep_ = 0; rep_ < 1 + DBL(9); ++rep_) { REFRESH();
        pg8::Gemm g{F.H, F.WFIN, MT, DFF2, DM}; pg8::StaticOrder S; S.init(MT, DFF2, F.G, (int)blockIdx.x);
        LAS int* SLOT = (LAS int*)(F.lds + LDSCTL_OFF + 1024); LAS float* RSL = (LAS float*)(F.lds + LDSCTL_OFF + 2048); LAS float* CWL = (LAS float*)(F.lds + LDSCTL_OFF + 8192);
#pragma unroll
        for (int i = 0; i < 6; ++i) { int upm = 0, upn = 0; const bool has = pg8::static_unit(MT / 256, DFF2 / 256, F.G, (int)blockIdx.x, i, upm, upn);
            if (has && F.tid < 256) { const f32x4* sp = (const f32x4*)(F.SSP + ((size_t)upm * 256 + F.tid) * 16); const f32x4 s4 = (sp[0] + sp[1]) + (sp[2] + sp[3]);
                RSL[i * 256 + F.tid] = rsqrtf(((s4[0] + s4[1]) + (s4[2] + s4[3])) * (1.f / 1024.f) + EPS); }
            if (has) { const int q = F.tid >> 7, cc = F.tid & 127; CWL[i * 512 + q * 128 + cc] = q == 0 ? F.conv_b[upn * 128 + cc] : F.conv_w[(size_t)(q - 1) * DFF + upn * 128 + cc]; }
            if (has && F.tid == 0) { SLOT[upm] = i; SLOT[128 + upn] = i; } }
        __syncthreads();
        pg8::EpiFfn E{F.GB, RSL, SLOT, CWL, F.RAW, F.HALO, MP, DFF};
        pg8::gemm_phase<pg8::EpiFfn, pg8::StaticOrder, true, true>(ring, g, S, E, F.tid);
        } SEAM(9);
    }
    if (IN(10)) { for (int rep_ = 0; rep_ < 1 + DBL(10); ++rep_) { REFRESH(); p10_fix(F); } SEAM(10); }
    if (IN(11)) { for (int rep_ = 0; rep_ < 1 + DBL(11); ++rep_) { REFRESH();
        pg8::Gemm g{F.GB, F.WFOUT, MP, DM, DFF}; pg8::StaticOrder S; S.init(MP, DM, F.G, (int)blockIdx.x);
        pg8::EpiRes E{F.X1, F.X1 + (size_t)MP * DM, F.out + O_YP, DM, MP};
        { const bool sf_ = MK_ONE_LAUNCH && (F.vcu & 1);
#pragma unroll 1
          for (int part_ = 0; part_ < 2; ++part_) {
            if ((part_ == 0) == sf_) { REFRESH(); small_gemm<DFF>(F, F.GB, F.WFOUT, EpiSRes{F.X1, F.out + O_YP}, F.tid, F.lane, F.wave); }
            else pg8::gemm_phase<pg8::EpiRes, pg8::StaticOrder, true, true>(ring, g, S, E, F.tid);
            __syncthreads(); REFRESH(); } }
    } }
#undef IN
#undef SEAM
#undef REFRESH
}

extern "C" void kernel_launch(void* const* d_in, const int* in_sizes, int n_in, void* d_out, int out_size, void* d_ws, size_t ws_size, hipStream_t stream) {
    static int grid = 0;
    if (grid == 0) {
        if (n_in != 24 || out_size != (int)O_END || ws_size < WS_END) { fprintf(stderr, "kernel_launch: unexpected sizes n_in %d out %d ws %zu\n", n_in, out_size, ws_size); grid = -1; return; }
        int dev = 0, cus = 0;
        if (hipGetDevice(&dev) != hipSuccess || hipDeviceGetAttribute(&cus, hipDeviceAttributeMultiprocessorCount, dev) != hipSuccess) { grid = -1; return; }
        if (hipFuncSetAttribute((const void*)fwd, hipFuncAttributeMaxDynamicSharedMemorySize, LDS_BYTES) != hipSuccess) { fprintf(stderr, "kernel_launch: hipFuncSetAttribute failed\n"); grid = -1; return; }
        int per_cu = 0;
        if (hipOccupancyMaxActiveBlocksPerMultiprocessor(&per_cu, (const void*)fwd, NWAVES * 64, LDS_BYTES) != hipSuccess || per_cu < 1) fprintf(stderr, "kernel_launch: occupancy query says %d\n", per_cu);
        (void)hipGetLastError();
        grid = cus;
    }
    if (grid < 0) return;
    (void)hipMemsetAsync((char*)d_ws + WS_CTL, 0, CTL_ZERO_BYTES, stream);
    Args a{};
    for (int i = 0; i < 24; ++i) a.in[i] = (const float*)d_in[i];
    a.out = (float*)d_out; a.ws = (unsigned char*)d_ws;
#if MK_ONE_LAUNCH
    a.ph_lo = 0; a.ph_hi = N_PHASES;
    hipLaunchKernelGGL(fwd, dim3(grid), dim3(NWAVES * 64), LDS_BYTES, stream, a);
#else
    for (int ph = 0; ph < N_PHASES; ++ph) { a.ph_lo = ph; a.ph_hi = ph + 1; hipLaunchKernelGGL(fwd, dim3(grid), dim3(NWAVES * 64), LDS_BYTES, stream, a); }
#endif
}
```
